# Optimizing an MI355X kernel written in HIP

```python
import jax, jax.numpy as jnp
from jax import lax
import numpy as np

D_MODEL = 1024
BATCH = 4
SEQ = 8192
DEPTH = 2

GRID_W = 64
CTX_LEN = 256
FOUR_GROUPS = 4
FOUR_GC = D_MODEL // 8
FOUR_WIDTH = FOUR_GROUPS * FOUR_GC
NA_HEADS = 8
NA_HEAD_DIM = D_MODEL // 16
NA_WIDTH = NA_HEADS * NA_HEAD_DIM
NA_WIN_ROWS = 8
NA_WIN_COLS = 16
POOL_SIZES = (2, 4, 8, 16)
POOL_GC = D_MODEL // len(POOL_SIZES)
MLP_HIDDEN = 4 * D_MODEL
N_MOD = 6
RMS_EPS = 1e-6
N_EVEN = (DEPTH + 1) // 2
N_ODD = DEPTH // 2

kernel_name = "hybrid_fnet_natten_pool_dit_block"


def rms_norm(x, g):
    xf = x.astype(jnp.float32)
    y = xf * lax.rsqrt(jnp.mean(xf * xf, axis=-1, keepdims=True) + RMS_EPS)
    return (y * g.astype(jnp.float32)).astype(x.dtype)


def modulate(xn, shift, scale):
    return xn * (1.0 + scale) + shift


def sq_relu_mlp(u, w1, w2):
    a = jnp.maximum(u @ w1, 0.0)
    return (a * a) @ w2


def fourier_mix(f, w_four):
    B, N, _ = f.shape
    fg = f.reshape(B, N, FOUR_GROUPS, FOUR_GC).transpose(0, 2, 1, 3)
    mixed = jnp.fft.fft2(fg.astype(jnp.float32), norm="ortho").real.astype(f.dtype)
    out = jnp.einsum('bgnc,gcd->bngd', mixed, w_four)
    return out.reshape(B, N, FOUR_WIDTH)


def neighbourhood_attention(q, k, v, k_ctx, v_ctx, rpb):
    B, N, H, dh = q.shape
    rows = N // GRID_W
    wr = min(NA_WIN_ROWS, rows)

    def to_grid(a):
        return a.reshape(B, rows, GRID_W, H, dh).transpose(0, 3, 1, 2, 4)

    qg, kg, vg = to_grid(q), to_grid(k), to_grid(v)
    r = jnp.arange(rows)
    row_start = jnp.clip(r - wr // 2, 0, rows - wr)
    row_idx = row_start[:, None] + jnp.arange(wr)[None, :]
    kb = kg[:, :, row_idx]
    vb = vg[:, :, row_idx]
    cidx = jnp.arange(GRID_W)
    col_start = jnp.clip(cidx - NA_WIN_COLS // 2, 0, GRID_W - NA_WIN_COLS)
    col_mask = (cidx[None, :] >= col_start[:, None]) & (cidx[None, :] < col_start[:, None] + NA_WIN_COLS)
    dr = row_idx - r[:, None] + (NA_WIN_ROWS - 1)
    dc = jnp.clip(cidx[None, :] - cidx[:, None] + (NA_WIN_COLS - 1), 0, 2 * NA_WIN_COLS - 2)
    bias = rpb[:, dr[:, None, :, None], dc[None, :, None, :]]
    scale = dh ** -0.5
    s_win = jnp.einsum('bhrqd,bhrjkd->bhrqjk', qg, kb).astype(jnp.float32) * scale + bias.astype(jnp.float32)
    s_win = jnp.where(col_mask[:, None, :], s_win, -jnp.inf)
    s_win = s_win.reshape(B, H, rows, GRID_W, wr * GRID_W)
    s_ctx = jnp.einsum('bhrqd,blhd->bhrql', qg, k_ctx).astype(jnp.float32) * scale
    p = jax.nn.softmax(jnp.concatenate([s_win, s_ctx], axis=-1), axis=-1)
    p_win = p[..., :wr * GRID_W].reshape(B, H, rows, GRID_W, wr, GRID_W).astype(v.dtype)
    p_ctx = p[..., wr * GRID_W:].astype(v.dtype)
    o = jnp.einsum('bhrqjk,bhrjkd->bhrqd', p_win, vb) + jnp.einsum('bhrql,blhd->bhrqd', p_ctx, v_ctx)
    return o.transpose(0, 2, 3, 1, 4).reshape(B, N, H * dh)


def context_attention(qc, kc, vc):
    B, L, H, dh = qc.shape
    s = jnp.einsum('blhd,bmhd->bhlm', qc, kc).astype(jnp.float32) * (dh ** -0.5)
    p = jax.nn.softmax(s, axis=-1).astype(vc.dtype)
    return jnp.einsum('bhlm,bmhd->blhd', p, vc).reshape(B, L, H * dh)


def split_heads(a):
    return a.reshape(a.shape[0], a.shape[1], NA_HEADS, NA_HEAD_DIM)


def even_mixer(u, uc, w_in, w_four, q_g, k_g, rpb, w_out, update_ctx):
    p = u @ w_in
    f, q, k, v = jnp.split(p, [FOUR_WIDTH, FOUR_WIDTH + NA_WIDTH, FOUR_WIDTH + 2 * NA_WIDTH], axis=-1)
    q = rms_norm(split_heads(q), q_g)
    k = rms_norm(split_heads(k), k_g)
    v = split_heads(v)
    kvc = uc @ w_in[:, FOUR_WIDTH + NA_WIDTH:]
    kc, vc = jnp.split(kvc, [NA_WIDTH], axis=-1)
    kc = rms_norm(split_heads(kc), k_g)
    vc = split_heads(vc)
    o_four = fourier_mix(f, w_four)
    o_na = neighbourhood_attention(q, k, v, kc, vc, rpb)
    y = jnp.concatenate([o_four, o_na], axis=-1) @ w_out
    if not update_ctx:
        return y, None
    fc, qc = jnp.split(uc @ w_in[:, :FOUR_WIDTH + NA_WIDTH], [FOUR_WIDTH], axis=-1)
    qc = rms_norm(split_heads(qc), q_g)
    yc = jnp.concatenate([fourier_mix(fc, w_four), context_attention(qc, kc, vc)], axis=-1) @ w_out
    return y, yc


def multiscale_pool(u):
    N = u.shape[1]
    uf = u.astype(jnp.float32)
    zeros = jnp.zeros((uf.shape[0], 1, uf.shape[2]), jnp.float32)
    cs = jnp.concatenate([zeros, jnp.cumsum(uf, axis=1)], axis=1)
    t = jnp.arange(N)
    outs = []
    for gi, w in enumerate(POOL_SIZES):
        sl = slice(gi * POOL_GC, (gi + 1) * POOL_GC)
        lo = jnp.clip(t - w // 2, 0, N)
        hi = jnp.clip(t + w - w // 2, 0, N)
        csg = cs[..., sl]
        s = jnp.take(csg, hi, axis=1) - jnp.take(csg, lo, axis=1)
        cnt = (hi - lo).astype(jnp.float32)[None, :, None]
        outs.append(s / cnt - uf[..., sl])
    return jnp.concatenate(outs, axis=-1).astype(u.dtype)


def pool_mixer(u, w_pool, pool_scale):
    B, N, _ = u.shape
    pooled = multiscale_pool(u).reshape(B, N, len(POOL_SIZES), POOL_GC)
    y = jnp.einsum('bngc,gcd->bngd', pooled, w_pool).reshape(B, N, D_MODEL)
    return y * pool_scale


def setup_inputs(seed: int = 0) -> dict:
    key = jax.random.key(seed)
    ks = jax.random.split(key, 20)
    f32 = jnp.float32
    n = lambda k, s: jax.random.normal(k, s, f32)
    return {
        "x": n(ks[0], (BATCH, SEQ, D_MODEL)),
        "c": n(ks[1], (BATCH, D_MODEL)),
        "ctx": n(ks[2], (BATCH, CTX_LEN, D_MODEL)),
        "c_ctx": n(ks[3], (D_MODEL,)),
        "w_mod": n(ks[4], (DEPTH, D_MODEL, N_MOD * D_MODEL)) * D_MODEL ** -0.5,
        "b_mod": n(ks[5], (DEPTH, N_MOD * D_MODEL)) * 0.02,
        "norm1_g": 1.0 + 0.02 * n(ks[6], (DEPTH, D_MODEL)),
        "norm2_g": 1.0 + 0.02 * n(ks[7], (DEPTH, D_MODEL)),
        "w_in_even": n(ks[8], (N_EVEN, D_MODEL, FOUR_WIDTH + 3 * NA_WIDTH)) * D_MODEL ** -0.5,
        "w_four": n(ks[9], (N_EVEN, FOUR_GROUPS, FOUR_GC, FOUR_GC)) * FOUR_GC ** -0.5,
        "q_norm_g": 1.0 + 0.02 * n(ks[10], (N_EVEN, NA_HEAD_DIM)),
        "k_norm_g": 1.0 + 0.02 * n(ks[11], (N_EVEN, NA_HEAD_DIM)),
        "rpb": 0.1 * n(ks[12], (N_EVEN, NA_HEADS, 2 * NA_WIN_ROWS - 1, 2 * NA_WIN_COLS - 1)),
        "w_out_even": n(ks[13], (N_EVEN, FOUR_WIDTH + NA_WIDTH, D_MODEL)) * (FOUR_WIDTH + NA_WIDTH) ** -0.5,
        "w_pool": n(ks[14], (N_ODD, len(POOL_SIZES), POOL_GC, POOL_GC)) * POOL_GC ** -0.5,
        "pool_scale": 1.0 + 0.1 * n(ks[15], (N_ODD, D_MODEL)),
        "w_mlp1": n(ks[16], (DEPTH, D_MODEL, MLP_HIDDEN)) * D_MODEL ** -0.5,
        "w_mlp2": n(ks[17], (DEPTH, MLP_HIDDEN, D_MODEL)) * MLP_HIDDEN ** -0.5,
    }


def reference(x, c, ctx, c_ctx, w_mod, b_mod, norm1_g, norm2_g, w_in_even, w_four, q_norm_g, k_norm_g,
              rpb, w_out_even, w_pool, pool_scale, w_mlp1, w_mlp2):
    h, hc = x, ctx
    sc = jax.nn.silu(c)
    scc = jax.nn.silu(c_ctx)
    for l in range(DEPTH):
        update_ctx = any(j % 2 == 0 for j in range(l + 1, DEPTH))
        need_ctx_in = (l % 2 == 0) or update_ctx
        mod = (sc @ w_mod[l] + b_mod[l])[:, None, :]
        sh1, sc1, g1, sh2, sc2, g2 = jnp.split(mod, N_MOD, axis=-1)
        u = modulate(rms_norm(h, norm1_g[l]), sh1, sc1)
        if need_ctx_in:
            mod_c = scc @ w_mod[l] + b_mod[l]
            csh1, csc1, cg1, csh2, csc2, cg2 = jnp.split(mod_c, N_MOD, axis=-1)
            uc = modulate(rms_norm(hc, norm1_g[l]), csh1, csc1)
        if l % 2 == 0:
            e = l // 2
            y, yc = even_mixer(u, uc, w_in_even[e], w_four[e], q_norm_g[e], k_norm_g[e], rpb[e],
                               w_out_even[e], update_ctx)
        else:
            o = l // 2
            y = pool_mixer(u, w_pool[o], pool_scale[o])
            yc = pool_mixer(uc, w_pool[o], pool_scale[o]) if update_ctx else None
        h = h + g1 * y
        h = h + g2 * sq_relu_mlp(modulate(rms_norm(h, norm2_g[l]), sh2, sc2), w_mlp1[l], w_mlp2[l])
        if update_ctx:
            hc = hc + cg1 * yc
            hc = hc + cg2 * sq_relu_mlp(modulate(rms_norm(hc, norm2_g[l]), csh2, csc2), w_mlp1[l], w_mlp2[l])
    return h
```

```cpp
#include <hip/hip_runtime.h>
#include <hip/hip_cooperative_groups.h>
#include <cstdio>
namespace cg = cooperative_groups;

#define LAS __attribute__((address_space(3)))
typedef unsigned short bf16_t;
typedef short bf16x8 __attribute__((ext_vector_type(8)));
typedef short s16x4 __attribute__((ext_vector_type(4)));
typedef float f32x4 __attribute__((ext_vector_type(4)));
typedef unsigned u32x4 __attribute__((ext_vector_type(4)));
typedef unsigned u32x2 __attribute__((ext_vector_type(2)));

constexpr int DM = 1024, NB = 4, SEQ = 8192, NT = NB * SEQ, CTXL = 256, NCTX = NB * CTXL, HID = 4096, NMOD = 6 * DM;
constexpr int PW = 2048;
constexpr int LDS_BYTES = 139264;

constexpr size_t al256(size_t x) { return (x + 255) & ~(size_t)255; }
constexpr size_t WS_CTL = 0;
constexpr size_t WS_MOD0 = 16384;
constexpr size_t WS_MOD1 = WS_MOD0 + al256((size_t)NB * NMOD * 4);
constexpr size_t WS_MODC = WS_MOD1 + al256((size_t)NB * NMOD * 4);
constexpr size_t WS_WIN = WS_MODC + al256(2048 * 4);
constexpr size_t WS_WOUT = WS_WIN + (size_t)PW * DM * 2;
constexpr size_t WS_W1 = WS_WOUT + (size_t)DM * DM * 2;
constexpr size_t WS_W2 = WS_W1 + (size_t)2 * HID * DM * 2;
constexpr size_t WS_WPOOL = WS_W2 + (size_t)2 * HID * DM * 2;
constexpr size_t WS_D1C = WS_WPOOL + (size_t)DM * 256 * 2;
constexpr size_t WS_D1S = WS_D1C + 128 * 128 * 2;
constexpr size_t WS_D2 = WS_D1S + 128 * 128 * 2;
constexpr size_t WS_U = WS_D2 + 64 * 128 * 2;
constexpr size_t WS_BIG = WS_U + (size_t)(NT + NCTX) * DM * 2;
constexpr size_t BIG_P = 0;
constexpr size_t BIG_S1 = BIG_P + (size_t)(NT + NCTX) * PW * 2;
constexpr size_t BIG_CAT = BIG_S1 + (size_t)NT * 1024 * 2;
constexpr size_t BIG_END = BIG_CAT + (size_t)NT * 1024 * 2;
constexpr size_t BIG_A = 0;
constexpr size_t BIG_POOL = 0;
constexpr size_t BIG_SIZE = BIG_END > (size_t)NT * HID * 2 ? BIG_END : (size_t)NT * HID * 2;
constexpr size_t WS_H = WS_BIG + BIG_SIZE;
constexpr size_t WS_END = WS_H + (size_t)NT * DM * 2;

struct Params {
    const float *x, *c, *ctx, *c_ctx, *w_mod, *b_mod, *norm1_g, *norm2_g, *w_in, *w_four, *q_g, *k_g, *rpb, *w_out, *w_pool, *pool_scale, *w_mlp1, *w_mlp2;
    float* out; unsigned char* ws;
};

typedef float f32x2 __attribute__((ext_vector_type(2)));
typedef __bf16 bf16x2v __attribute__((ext_vector_type(2)));
__device__ __forceinline__ unsigned cvt_pk_bf16(float lo, float hi) { const f32x2 f = {lo, hi}; const bf16x2v b = __builtin_convertvector(f, bf16x2v); return __builtin_bit_cast(unsigned, b); }
__device__ __forceinline__ float bf_lo(unsigned u) { return __uint_as_float(u << 16); }
__device__ __forceinline__ float bf_hi(unsigned u) { return __uint_as_float(u & 0xffff0000u); }
template <bool BF> __device__ __forceinline__ f32x4 ld4(const void* base, size_t idx) {
    if (BF) { const u32x2 v = *(const u32x2*)((const bf16_t*)base + idx); return (f32x4){bf_lo(v.x), bf_hi(v.x), bf_lo(v.y), bf_hi(v.y)}; }
    else return *(const f32x4*)((const float*)base + idx);
}
template <bool BF> __device__ __forceinline__ void st4(void* base, size_t idx, const f32x4 v) {
    if (BF) *(u32x2*)((bf16_t*)base + idx) = (u32x2){cvt_pk_bf16(v[0], v[1]), cvt_pk_bf16(v[2], v[3])};
    else *(f32x4*)((float*)base + idx) = v;
}
template <bool BF> __device__ __forceinline__ void ld8(const void* base, size_t idx, f32x4& a, f32x4& b) {
    if (BF) { const u32x4 v = *(const u32x4*)((const bf16_t*)base + idx); a = (f32x4){bf_lo(v.x), bf_hi(v.x), bf_lo(v.y), bf_hi(v.y)}; b = (f32x4){bf_lo(v.z), bf_hi(v.z), bf_lo(v.w), bf_hi(v.w)}; }
    else { a = *(const f32x4*)((const float*)base + idx); b = *(const f32x4*)((const float*)base + idx + 4); }
}
template <bool BF> __device__ __forceinline__ void st8(void* base, size_t idx, const f32x4 a, const f32x4 b) {
    if (BF) { u32x4 w; w.x = cvt_pk_bf16(a[0], a[1]); w.y = cvt_pk_bf16(a[2], a[3]); w.z = cvt_pk_bf16(b[0], b[1]); w.w = cvt_pk_bf16(b[2], b[3]); *(u32x4*)((bf16_t*)base + idx) = w; }
    else { *(f32x4*)((float*)base + idx) = a; *(f32x4*)((float*)base + idx + 4) = b; }
}
__device__ __forceinline__ int phys_row(int n, int mode) {
    const int L = n & 255, wc = L >> 6, bj = (L >> 5) & 1, j = L & 3;
    const int fq = mode ? ((L >> 2) & 3) : ((L >> 3) & 3), nn = mode ? ((L >> 4) & 1) : ((L >> 2) & 1);
    return (n & ~255) + 128 * bj + 32 * wc + 16 * nn + 4 * fq + j;
}

constexpr int BM = 256, BK = 64, HALF = 128, HTB = HALF * BK * 2, NXCD = 8, WGM = 8;
__device__ __forceinline__ int lds_byte(int r, int c) { const int st = (r >> 4) * 2 + (c >> 5), rr = r & 15, cc = c & 31, ob = rr * 64 + cc * 2; return st * 1024 + (ob ^ (((ob >> 9) & 1) << 5)); }
__device__ __forceinline__ void stage_rc(int b, int& R, int& C) { const int st = b / 1024, sb = b % 1024, swz = sb ^ (((sb >> 9) & 1) << 5); R = (st >> 1) * 16 + swz / 64; C = (st & 1) * 32 + (swz % 64) / 2; }
struct Unit { int pm, pn; };
struct Gemm { const bf16_t* A; const bf16_t* Bt; int lda, ldb, K, nM, nN, a_pn_bytes, a_blk, b_blk; };
__device__ __forceinline__ size_t blk_off(int row, int col, int nkt) { return ((size_t)(row >> 7) * nkt + (col >> 6)) * 16384 + lds_byte(row & 127, col & 63); }
struct StaticOrder {
    int nM, nN, nwg, G, c;
    __device__ void init(int nM_, int nN_, int G_, int c_) { nM = nM_; nN = nN_; nwg = nM * nN; G = G_; c = c_; }
    __device__ bool next(int i, Unit& u) const {
        const long L = (long)i * G + c; if (L >= nwg) return false;
        int wgid = (int)L; { const int q = nwg / NXCD, r = nwg % NXCD, xcd = wgid % NXCD, off = wgid / NXCD; wgid = (xcd < r ? xcd * (q + 1) : r * (q + 1) + (xcd - r) * q) + off; }
        const int nig = WGM * nN, gid = wgid / nig, fm = gid * WGM, gsz = (nM - fm) < WGM ? (nM - fm) : WGM;
        u.pm = fm + ((wgid % nig) % gsz); u.pn = (wgid % nig) / gsz; return true;
    }
};

template <class Epi>
__device__ __forceinline__ void gemm_phase(LAS unsigned char* lds, const Gemm g, const Epi& E) {
    const int tid = threadIdx.x, wid = __builtin_amdgcn_readfirstlane(tid >> 6), lane = tid & 63, wr = wid >> 2, wc = wid & 3, fr = lane & 15, fq = lane >> 4;
    const int K = g.K, nt = K / BK;
    StaticOrder S; S.init(g.nM, g.nN, (int)gridDim.x, (int)blockIdx.x);
    unsigned voffA[2], voffB[2];
#pragma unroll
    for (int i = 0; i < 2; ++i) { int R, C; stage_rc(tid * 16 + i * 8192, R, C); voffA[i] = g.a_blk ? (unsigned)(tid * 16 + i * 8192) : (unsigned)(R * g.lda + C) * 2u; voffB[i] = g.b_blk ? (unsigned)(tid * 16 + i * 8192) : (unsigned)(R * g.ldb + C) * 2u; }
    const size_t kstepA = g.a_blk ? (size_t)16384 : (size_t)(BK * 2), kstepB = g.b_blk ? (size_t)16384 : (size_t)(BK * 2);
    const size_t hstepA = g.a_blk ? (size_t)g.a_blk * 16384 : (size_t)HALF * g.lda * 2, hstepB = g.b_blk ? (size_t)g.b_blk * 16384 : (size_t)HALF * g.ldb * 2;
    const size_t tstepA = 2 * hstepA, tstepB = 2 * hstepB;
    const unsigned ldsw = (unsigned)wid * 1024u;
    const int aoff = lds_byte(wr * 64 + fr, fq * 8), boff = lds_byte(wc * 32 + fr, fq * 8);
#define G_SA(b, h) (((b) * 2 + (h)) * HTB)
#define G_SB(b, h) ((4 + (b) * 2 + (h)) * HTB)
#define G_STAGE(bufoff, gbase, voff) do { _Pragma("unroll") for (int _i = 0; _i < 2; ++_i) \
        __builtin_amdgcn_global_load_lds((const unsigned*)((const char*)(gbase) + (voff)[_i]), (LAS unsigned*)(lds + (bufoff) + ldsw + _i * 8192), 16, 0, 0); } while (0)
#define G_LDA(dst, b, h) do { _Pragma("unroll") for (int m = 0; m < 4; ++m) _Pragma("unroll") for (int k = 0; k < 2; ++k) dst[m][k] = *(const LAS bf16x8*)(lds + G_SA(b, h) + aoff + m * 2048 + k * 1024); } while (0)
#define G_LDB(dst, b, h) do { _Pragma("unroll") for (int n = 0; n < 2; ++n) _Pragma("unroll") for (int k = 0; k < 2; ++k) dst[n][k] = *(const LAS bf16x8*)(lds + G_SB(b, h) + boff + n * 2048 + k * 1024); } while (0)
#define G_MMA(ai, bj, At, Bt) do { __builtin_amdgcn_s_setprio(1); _Pragma("unroll") for (int m = 0; m < 4; ++m) _Pragma("unroll") for (int n = 0; n < 2; ++n) _Pragma("unroll") for (int k = 0; k < 2; ++k) \
        acc[ai][bj][m][n] = __builtin_amdgcn_mfma_f32_16x16x32_bf16(Bt[n][k], At[m][k], acc[ai][bj][m][n], 0, 0, 0); __builtin_amdgcn_s_setprio(0); } while (0)
#define G_WAIT_V(n) asm volatile("s_waitcnt vmcnt(" #n ")" ::: "memory")
#define G_WAIT_L(n) asm volatile("s_waitcnt lgkmcnt(" #n ")" ::: "memory")
#define G_BAR __builtin_amdgcn_s_barrier()
#define G_SCHED __builtin_amdgcn_sched_barrier(0)
    Unit cur, nxt; int ui = 0;
    if (!S.next(0, cur)) return;
    f32x4 acc[2][2][4][2];
#pragma unroll
    for (int a = 0; a < 2; ++a)
#pragma unroll
        for (int b = 0; b < 2; ++b)
#pragma unroll
            for (int m = 0; m < 4; ++m)
#pragma unroll
                for (int n = 0; n < 2; ++n) acc[a][b][m][n] = (f32x4){0.f, 0.f, 0.f, 0.f};
    bf16x8 At[4][2], B0[2][2], B1[2][2];
    const char* cA = (const char*)g.A + (size_t)cur.pm * tstepA + (size_t)cur.pn * g.a_pn_bytes; const char* cB = (const char*)g.Bt + (size_t)cur.pn * tstepB;
    G_STAGE(G_SB(0, 0), cB, voffB); G_STAGE(G_SA(0, 0), cA, voffA); G_STAGE(G_SB(0, 1), cB + hstepB, voffB); G_STAGE(G_SA(0, 1), cA + hstepA, voffA);
    if (wr == 1) G_BAR;
    G_WAIT_V(4); G_BAR;
    G_STAGE(G_SB(1, 0), cB + kstepB, voffB); G_STAGE(G_SA(1, 0), cA + kstepA, voffA); G_STAGE(G_SB(1, 1), cB + hstepB + kstepB, voffB);
    G_WAIT_V(6); G_BAR;
    for (;;) {
        const bool has_next = S.next(ui + 1, nxt);
        const char* nA = has_next ? (const char*)g.A + (size_t)nxt.pm * tstepA + (size_t)nxt.pn * g.a_pn_bytes : cA; const char* nB = has_next ? (const char*)g.Bt + (size_t)nxt.pn * tstepB : cB;
        for (int t = 0; t < nt; t += 2) {
            const bool last = (t == nt - 2);
            const char* a1 = cA + (size_t)(t + 1) * kstepA;
            const char* a2 = last ? nA : cA + (size_t)(t + 2) * kstepA; const char* b2 = last ? nB : cB + (size_t)(t + 2) * kstepB;
            const char* a3 = a2 + kstepA; const char* b3 = b2 + kstepB;
            G_LDB(B0, 0, 0); G_SCHED; G_LDA(At, 0, 0); G_STAGE(G_SA(1, 1), a1 + hstepA, voffA);
            G_WAIT_L(8); G_BAR; G_WAIT_L(0); G_MMA(0, 0, At, B0); G_BAR; G_SCHED;
            G_LDB(B1, 0, 1); G_STAGE(G_SB(0, 0), b2, voffB);
            G_BAR; G_WAIT_L(0); G_MMA(0, 1, At, B1); G_BAR;
            G_LDA(At, 0, 1); G_STAGE(G_SA(0, 0), a2, voffA);
            G_BAR; G_WAIT_L(0); G_MMA(1, 0, At, B0); G_BAR; G_SCHED;
            G_STAGE(G_SB(0, 1), b2 + hstepB, voffB);
            G_WAIT_V(6); G_BAR; G_MMA(1, 1, At, B1); G_BAR;
            G_LDB(B0, 1, 0); G_SCHED; G_LDA(At, 1, 0); G_STAGE(G_SA(0, 1), a2 + hstepA, voffA);
            G_WAIT_L(8); G_BAR; G_WAIT_L(0); G_MMA(0, 0, At, B0); G_BAR; G_SCHED;
            G_LDB(B1, 1, 1); G_STAGE(G_SB(1, 0), b3, voffB);
            G_BAR; G_WAIT_L(0); G_MMA(0, 1, At, B1); G_BAR;
            G_LDA(At, 1, 1); G_STAGE(G_SA(1, 0), a3, voffA);
            G_BAR; G_WAIT_L(0); G_MMA(1, 0, At, B0); G_BAR; G_SCHED;
            G_STAGE(G_SB(1, 1), b3 + hstepB, voffB);
            G_WAIT_V(6); G_BAR; G_MMA(1, 1, At, B1); G_BAR;
        }
        E(acc, cur, wr, wc, fr, fq);
        if (!has_next) break;
#pragma unroll
        for (int a = 0; a < 2; ++a)
#pragma unroll
            for (int b = 0; b < 2; ++b)
#pragma unroll
                for (int m = 0; m < 4; ++m)
#pragma unroll
                    for (int n = 0; n < 2; ++n) acc[a][b][m][n] = (f32x4){0.f, 0.f, 0.f, 0.f};
        cur = nxt; cA = nA; cB = nB; ++ui;
    }
    G_WAIT_V(0);
    if (wr == 0) G_BAR;
    G_BAR;
#undef G_SA
#undef G_SB
#undef G_STAGE
#undef G_LDA
#undef G_LDB
#undef G_MMA
#undef G_WAIT_V
#undef G_WAIT_L
#undef G_BAR
#undef G_SCHED
}

__device__ __forceinline__ void store16_bf16(bf16_t* dst, const float (&v)[16]) {
    u32x4 w0, w1;
    w0.x = cvt_pk_bf16(v[0], v[1]); w0.y = cvt_pk_bf16(v[2], v[3]); w0.z = cvt_pk_bf16(v[4], v[5]); w0.w = cvt_pk_bf16(v[6], v[7]);
    w1.x = cvt_pk_bf16(v[8], v[9]); w1.y = cvt_pk_bf16(v[10], v[11]); w1.z = cvt_pk_bf16(v[12], v[13]); w1.w = cvt_pk_bf16(v[14], v[15]);
    *(u32x4*)dst = w0; *(u32x4*)(dst + 8) = w1;
}
__device__ __forceinline__ void store8_bf16(bf16_t* dst, const f32x4 a, const f32x4 b) {
    u32x4 w; w.x = cvt_pk_bf16(a[0], a[1]); w.y = cvt_pk_bf16(a[2], a[3]); w.z = cvt_pk_bf16(b[0], b[1]); w.w = cvt_pk_bf16(b[2], b[3]);
    *(u32x4*)dst = w;
}
struct EpiProj {
    bf16_t* P; const float* qg; const float* kg;
    __device__ __forceinline__ void operator()(const f32x4 (&acc)[2][2][4][2], const Unit& u, int wr, int wc, int fr, int fq) const {
        const int row0 = u.pm * BM + wr * 64 + fr, col0 = u.pn * BM + wc * 64 + fq * 8;
        const bool hn = (u.pn >= 2 && u.pn < 6);
        const float qs = (u.pn < 4) ? 0.18033688011112042f : 1.0f;
        f32x4 gv[2][2];
        if (hn) { const float* gp = (u.pn < 4 ? qg : kg) + fq * 8;
#pragma unroll
            for (int bj = 0; bj < 2; ++bj)
#pragma unroll
                for (int n = 0; n < 2; ++n) gv[bj][n] = *(const f32x4*)(gp + 32 * bj + 4 * n); }
#pragma unroll
        for (int ai = 0; ai < 2; ++ai)
#pragma unroll
            for (int m = 0; m < 4; ++m) {
                f32x4 v[2][2];
#pragma unroll
                for (int bj = 0; bj < 2; ++bj)
#pragma unroll
                    for (int n = 0; n < 2; ++n) v[bj][n] = acc[ai][bj][m][n];
                if (hn) {
                    float ss = 0.f;
#pragma unroll
                    for (int bj = 0; bj < 2; ++bj)
#pragma unroll
                        for (int n = 0; n < 2; ++n) ss += v[bj][n][0] * v[bj][n][0] + v[bj][n][1] * v[bj][n][1] + v[bj][n][2] * v[bj][n][2] + v[bj][n][3] * v[bj][n][3];
                    ss += __shfl_xor(ss, 16); ss += __shfl_xor(ss, 32);
                    const float rs = rsqrtf(ss * (1.0f / 64.0f) + 1e-6f);
#pragma unroll
                    for (int bj = 0; bj < 2; ++bj)
#pragma unroll
                        for (int n = 0; n < 2; ++n) v[bj][n] = v[bj][n] * (rs * qs) * gv[bj][n];
                }
                bf16_t* dst = P + (size_t)(row0 + ai * HALF + m * 16) * PW + col0;
                store8_bf16(dst, v[0][0], v[0][1]); store8_bf16(dst + 32, v[1][0], v[1][1]);
            }
    }
};
struct EpiAct {
    bf16_t* O; int ldo;
    __device__ __forceinline__ void operator()(const f32x4 (&acc)[2][2][4][2], const Unit& u, int wr, int wc, int fr, int fq) const {
        const int row0 = u.pm * BM + wr * 64 + fr, col0 = u.pn * BM + wc * 64 + fq * 8;
#pragma unroll
        for (int ai = 0; ai < 2; ++ai)
#pragma unroll
            for (int m = 0; m < 4; ++m) {
                const int row = row0 + ai * HALF + m * 16;
#pragma unroll
                for (int bj = 0; bj < 2; ++bj) { f32x4 a = acc[ai][bj][m][0], b = acc[ai][bj][m][1];
                    bf16_t* dst = (bf16_t*)((char*)O + blk_off(row, col0 + 32 * bj, ldo / 64));
#pragma unroll
                    for (int j = 0; j < 4; ++j) { const float ra = fmaxf(a[j], 0.f), rb = fmaxf(b[j], 0.f); a[j] = ra * ra; b[j] = rb * rb; }
                    store8_bf16(dst, a, b); }
            }
    }
};
template <bool RB, bool OB> struct EpiResT {
    const void* res; void* out; const float* gate; const float* cscale;
    __device__ __forceinline__ void operator()(const f32x4 (&acc)[2][2][4][2], const Unit& u, int wr, int wc, int fr, int fq) const {
        const int row0 = u.pm * BM + wr * 64 + fr, col0 = u.pn * BM + wc * 64 + fq * 8;
        const int b = u.pm >> 5;
        f32x4 gv[2][2];
#pragma unroll
        for (int bj = 0; bj < 2; ++bj)
#pragma unroll
            for (int n = 0; n < 2; ++n) { f32x4 t = *(const f32x4*)(gate + (size_t)b * NMOD + col0 + 32 * bj + 4 * n);
                if (cscale) { const f32x4 s = *(const f32x4*)(cscale + col0 + 32 * bj + 4 * n); t = t * s; }
                gv[bj][n] = t; }
#pragma unroll
        for (int ai = 0; ai < 2; ++ai)
#pragma unroll
            for (int m = 0; m < 4; ++m) {
                const size_t off = (size_t)(row0 + ai * HALF + m * 16) * DM + col0;
#pragma unroll
                for (int bj = 0; bj < 2; ++bj) { f32x4 r0, r1; ld8<RB>(res, off + 32 * bj, r0, r1);
                    st8<OB>(out, off + 32 * bj, r0 + gv[bj][0] * acc[ai][bj][m][0], r1 + gv[bj][1] * acc[ai][bj][m][1]); }
            }
    }
};

__device__ void mod_task(const Params& P, int t, LAS float* sl) {
    const int tid = threadIdx.x, l = t / 96, n0 = (t % 96) * 64;
#pragma unroll
    for (int i = tid; i < 5 * 1024; i += 512) { const float v = (i < 4096) ? P.c[i] : P.c_ctx[i - 4096]; sl[i] = v / (1.0f + expf(-v)); }
    __syncthreads();
    const int kg = tid >> 6, ln = tid & 63;
    const float* w = P.w_mod + (size_t)l * DM * NMOD + n0 + ln;
    float a0 = 0.f, a1 = 0.f, a2 = 0.f, a3 = 0.f, a4 = 0.f;
#pragma unroll 8
    for (int k = kg * 128; k < kg * 128 + 128; ++k) { const float wv = w[(size_t)k * NMOD]; a0 += sl[k] * wv; a1 += sl[1024 + k] * wv; a2 += sl[2048 + k] * wv; a3 += sl[3072 + k] * wv; a4 += sl[4096 + k] * wv; }
    LAS float* red = sl + 5 * 1024;
    red[(kg * 5 + 0) * 64 + ln] = a0; red[(kg * 5 + 1) * 64 + ln] = a1; red[(kg * 5 + 2) * 64 + ln] = a2; red[(kg * 5 + 3) * 64 + ln] = a3; red[(kg * 5 + 4) * 64 + ln] = a4;
    __syncthreads();
    if (tid < 320) { const int r = tid >> 6, n = tid & 63; float s = 0.f;
        for (int g = 0; g < 8; ++g) s += red[(g * 5 + r) * 64 + n];
        s += P.b_mod[l * NMOD + n0 + n];
        float* modl = (float*)(P.ws + (l ? WS_MOD1 : WS_MOD0));
        if (r < 4) modl[r * NMOD + n0 + n] = s; else if (l == 0 && n0 + n < 2048) ((float*)(P.ws + WS_MODC))[n0 + n] = s; }
    __syncthreads();
}
__device__ void fold_win_task(const Params& P, int t, LAS float* sl) {
    const int tid = threadIdx.x, g = t >> 4, k0 = (t & 15) * 64;
    LAS float* wt = sl;
    LAS float* ctab = sl + 64 * 132;
    { const int r = tid >> 5, c4 = tid & 31;
#pragma unroll
        for (int i = 0; i < 4; ++i) { const f32x4 v = *(const f32x4*)(P.w_in + (size_t)(k0 + r + 16 * i) * PW + g * 128 + c4 * 4); LAS float* d = wt + (r + 16 * i) * 132 + c4 * 4; d[0] = v[0]; d[1] = v[1]; d[2] = v[2]; d[3] = v[3]; } }
    if (tid < 128) ctab[tid] = cospif((float)tid * (1.0f / 64.0f));
    __syncthreads();
    const int jj = tid & 127, kq = tid >> 7;
    float acc[16];
#pragma unroll
    for (int i = 0; i < 16; ++i) acc[i] = 0.f;
    const int mul = (jj <= 64) ? jj : (jj - 64), sub = (jj <= 64) ? 0 : 32;
    for (int c = 0; c < 128; c += 4) {
        const float d0 = ctab[(mul * c - sub) & 127], d1 = ctab[(mul * (c + 1) - sub) & 127], d2 = ctab[(mul * (c + 2) - sub) & 127], d3 = ctab[(mul * (c + 3) - sub) & 127];
#pragma unroll
        for (int i = 0; i < 16; ++i) { const f32x4 w = *(const LAS f32x4*)(wt + (kq * 16 + i) * 132 + c); acc[i] += w[0] * d0 + w[1] * d1 + w[2] * d2 + w[3] * d3; }
    }
    bf16_t* dst = (bf16_t*)(P.ws + WS_WIN) + (size_t)phys_row(g * 128 + jj, 0) * DM + k0 + kq * 16;
    store16_bf16(dst, acc);
    __syncthreads();
}
__device__ void fold_wout_task(const Params& P, int t, LAS float* sl) {
    const int tid = threadIdx.x, g = t >> 4, d0 = (t & 15) * 64;
    LAS float* wfp = sl;
    LAS float* wo = sl + 128 * 128;
    const float* base = P.w_four + (size_t)g * 128 * 128;
#pragma unroll 8
    for (int idx = tid; idx < 128 * 128; idx += 512) { const int jj = idx >> 7, e = idx & 127; float v;
        if (jj == 0 || jj == 64) v = base[jj * 128 + e];
        else if (jj < 64) v = base[jj * 128 + e] + base[(128 - jj) * 128 + e];
        else { const int l = jj - 64; v = base[(128 - l) * 128 + e] - base[l * 128 + e]; }
        wfp[idx] = v; }
    { const int r = tid >> 4, c4 = tid & 15;
#pragma unroll
        for (int i = 0; i < 4; ++i) { const f32x4 v = *(const f32x4*)(P.w_out + (size_t)(g * 128 + r + 32 * i) * DM + d0 + c4 * 4); LAS float* d = wo + (r + 32 * i) * 64 + c4 * 4; d[0] = v[0]; d[1] = v[1]; d[2] = v[2]; d[3] = v[3]; } }
    __syncthreads();
    const int dd = tid & 63, jq = tid >> 6;
    float acc[16];
#pragma unroll
    for (int i = 0; i < 16; ++i) acc[i] = 0.f;
    for (int e = 0; e < 128; e += 4) {
        const float w0 = wo[e * 64 + dd], w1 = wo[(e + 1) * 64 + dd], w2 = wo[(e + 2) * 64 + dd], w3 = wo[(e + 3) * 64 + dd];
#pragma unroll
        for (int i = 0; i < 16; ++i) { const f32x4 f = *(const LAS f32x4*)(wfp + (jq * 16 + i) * 128 + e); acc[i] += f[0] * w0 + f[1] * w1 + f[2] * w2 + f[3] * w3; }
    }
    bf16_t* dst = (bf16_t*)(P.ws + WS_WOUT) + (size_t)phys_row(d0 + dd, 0) * DM + g * 128 + jq * 16;
    store16_bf16(dst, acc);
    __syncthreads();
}
__device__ void conv_tile(const float* src, int ld, int k0, int n0, bf16_t* dst, int ldd, int kdst0, int ndst0, int mode, LAS float* sl, int blocked = 0) {
    const int tid = threadIdx.x;
    { const int r = tid >> 4, c4 = tid & 15;
        f32x4 v[4][2];
#pragma unroll
        for (int t = 0; t < 4; ++t)
#pragma unroll
            for (int i = 0; i < 2; ++i) v[t][i] = *(const f32x4*)(src + (size_t)(k0 + r + 32 * i) * ld + n0 + t * 64 + c4 * 4);
#pragma unroll
        for (int t = 0; t < 4; ++t)
#pragma unroll
            for (int i = 0; i < 2; ++i) { LAS float* d = sl + t * (64 * 65) + (r + 32 * i) * 65 + c4 * 4; d[0] = v[t][i][0]; d[1] = v[t][i][1]; d[2] = v[t][i][2]; d[3] = v[t][i][3]; } }
    __syncthreads();
    { const int nn = tid >> 3, kc = tid & 7;
#pragma unroll
        for (int t = 0; t < 4; ++t) { float v[8];
#pragma unroll
            for (int i = 0; i < 8; ++i) v[i] = sl[t * (64 * 65) + (kc * 8 + i) * 65 + nn];
            u32x4 w; w.x = cvt_pk_bf16(v[0], v[1]); w.y = cvt_pk_bf16(v[2], v[3]); w.z = cvt_pk_bf16(v[4], v[5]); w.w = cvt_pk_bf16(v[6], v[7]);
            const int prow = phys_row(ndst0 + n0 + t * 64 + nn, mode), pcol = kdst0 + k0 + kc * 8;
            if (blocked) *(u32x4*)((char*)dst + blk_off(prow, pcol, ldd / 64)) = w; else *(u32x4*)(dst + (size_t)prow * ldd + pcol) = w; } }
    __syncthreads();
}
__device__ void dft_tab_task(const Params& P) {
    bf16_t* d1c = (bf16_t*)(P.ws + WS_D1C); bf16_t* d1s = (bf16_t*)(P.ws + WS_D1S); bf16_t* d2 = (bf16_t*)(P.ws + WS_D2);
    for (int idx = threadIdx.x; idx < 128 * 128; idx += 512) { const int ka = idx >> 7, a = idx & 127; const float ang = (float)((ka * a) & 127) * (1.0f / 64.0f);
        d1c[idx] = (bf16_t)(cvt_pk_bf16(cospif(ang), 0.f) & 0xffff); d1s[idx] = (bf16_t)(cvt_pk_bf16(-sinpif(ang), 0.f) & 0xffff); }
    for (int idx = threadIdx.x; idx < 64 * 128; idx += 512) { const int kb = idx >> 7, kk = idx & 127, bb = kk >> 1; const float ang = (float)((kb * bb) & 63) * (1.0f / 32.0f);
        const float v = ((kk & 1) ? sinpif(ang) : cospif(ang)) * (1.0f / 32.0f);
        d2[idx] = (bf16_t)(cvt_pk_bf16(v, 0.f) & 0xffff); }
}
__device__ void phase0(const Params& P, LAS unsigned char* lds) {
    LAS float* sl = (LAS float*)lds;
    constexpr int T_MOD = 192, T_FWIN = 64, T_FWOUT = 64, T_W1 = 512, T_W2 = 512, T_WIN = 96, T_WOUT = 32, T_POOL = 16, T_DFT = 1;
    constexpr int NTASK = T_MOD + T_FWIN + T_FWOUT + T_W1 + T_W2 + T_WIN + T_WOUT + T_POOL + T_DFT;
    unsigned* qhead = (unsigned*)(P.ws + WS_CTL) + 3600;
    volatile LAS unsigned* qslot = (volatile LAS unsigned*)(lds + LDS_BYTES - 8);
    for (;;) {
        __syncthreads();
        if (threadIdx.x == 0) *qslot = __hip_atomic_fetch_add(qhead, 1u, __ATOMIC_RELAXED, __HIP_MEMORY_SCOPE_AGENT);
        __syncthreads();
        const int t = (int)*qslot;
        if (t >= NTASK) break;
        int q = t;
        if (q < T_MOD) { mod_task(P, q, sl); continue; } q -= T_MOD;
        if (q < T_FWIN) { fold_win_task(P, q, sl); continue; } q -= T_FWIN;
        if (q < T_FWOUT) { fold_wout_task(P, q, sl); continue; } q -= T_FWOUT;
        if (q < T_W1) { const int l = q >> 8, r = q & 255, kt = r >> 4, ntile = r & 15;
            conv_tile(P.w_mlp1 + (size_t)l * DM * HID, HID, kt * 64, ntile * 256, (bf16_t*)(P.ws + WS_W1) + (size_t)l * HID * DM, DM, 0, 0, 0, sl); continue; } q -= T_W1;
        if (q < T_W2) { const int l = q >> 8, r = q & 255, kt = r >> 2, ntile = r & 3;
            conv_tile(P.w_mlp2 + (size_t)l * HID * DM, DM, kt * 64, ntile * 256, (bf16_t*)(P.ws + WS_W2) + (size_t)l * DM * HID, HID, 0, 0, 0, sl, 1); continue; } q -= T_W2;
        if (q < T_WIN) { const int kt = q / 6, ntile = q % 6;
            conv_tile(P.w_in, PW, kt * 64, 512 + ntile * 256, (bf16_t*)(P.ws + WS_WIN), DM, 0, 0, 0, sl); continue; } q -= T_WIN;
        if (q < T_WOUT) { const int kt = q >> 2, ntile = q & 3;
            conv_tile(P.w_out + (size_t)512 * DM, DM, kt * 64, ntile * 256, (bf16_t*)(P.ws + WS_WOUT), DM, 512, 0, 0, sl); continue; } q -= T_WOUT;
        if (q < T_POOL) { const int g = q >> 2, kt = q & 3;
            conv_tile(P.w_pool + (size_t)g * 256 * 256, 256, kt * 64, 0, (bf16_t*)(P.ws + WS_WPOOL), 256, 0, g * 256, 0, sl); continue; } q -= T_POOL;
        dft_tab_task(P);
    }
}

template <int NR, bool SB>
__device__ __forceinline__ void norm_rows(const void* src, size_t srow, bf16_t* dst, const f32x4 (&gs)[4], const f32x4 (&sh)[4], int lane, bf16_t* cpy = nullptr) {
    f32x4 v[NR][4]; float ss[NR];
#pragma unroll
    for (int r = 0; r < NR; ++r)
#pragma unroll
        for (int j = 0; j < 2; ++j) ld8<SB>(src, (srow + r) * DM + j * 512 + lane * 8, v[r][2 * j], v[r][2 * j + 1]);
#pragma unroll
    for (int r = 0; r < NR; ++r) { ss[r] = 0.f;
#pragma unroll
        for (int i = 0; i < 4; ++i) ss[r] += v[r][i][0] * v[r][i][0] + v[r][i][1] * v[r][i][1] + v[r][i][2] * v[r][i][2] + v[r][i][3] * v[r][i][3]; }
#pragma unroll
    for (int o = 32; o >= 1; o >>= 1)
#pragma unroll
        for (int r = 0; r < NR; ++r) ss[r] += __shfl_xor(ss[r], o);
#pragma unroll
    for (int r = 0; r < NR; ++r) { const float rs = rsqrtf(ss[r] * (1.0f / 1024.0f) + 1e-6f);
#pragma unroll
        for (int j = 0; j < 2; ++j) { const f32x4 a = v[r][2 * j] * rs * gs[2 * j] + sh[2 * j], b = v[r][2 * j + 1] * rs * gs[2 * j + 1] + sh[2 * j + 1];
            st8<true>(dst, (size_t)r * DM + j * 512 + lane * 8, a, b);
            if (cpy) st8<true>(cpy, (size_t)r * DM + j * 512 + lane * 8, v[r][2 * j], v[r][2 * j + 1]); } }
}
__device__ __forceinline__ void load_mod_vecs(const float* gn, const float* shift, const float* scale, f32x4 (&gs)[4], f32x4 (&sh)[4], int lane) {
#pragma unroll
    for (int i = 0; i < 4; ++i) { const int c = (i >> 1) * 512 + lane * 8 + (i & 1) * 4; const f32x4 g = *(const f32x4*)(gn + c), s = *(const f32x4*)(scale + c); gs[i] = g * (s + 1.0f); sh[i] = *(const f32x4*)(shift + c); }
}
template <bool SB>
__device__ __forceinline__ void norm_pass(const void* src, bf16_t* dst, const float* gn, const float* mod, int which, const Params* Pctx, bf16_t* cpy = nullptr) {
    int ltid_ = threadIdx.x; asm volatile("" : "+v"(ltid_));
    const int lane = ltid_ & 63, gw = blockIdx.x * 8 + (ltid_ >> 6), nw = gridDim.x * 8;
    f32x4 gs[4], sh[4];
    int curb = -1;
    for (int r = gw * 4; r < NT; r += nw * 4) {
        const int b = r >> 13;
        if (b != curb) { curb = b; load_mod_vecs(gn, mod + (size_t)b * NMOD + which * 3072, mod + (size_t)b * NMOD + which * 3072 + 1024, gs, sh, lane); }
        norm_rows<4, SB>(src, (size_t)r, dst + (size_t)r * DM, gs, sh, lane, cpy ? cpy + (size_t)r * DM : nullptr);
    }
    if (Pctx) {
        const float* modc = (const float*)(Pctx->ws + WS_MODC);
        load_mod_vecs(gn, modc, modc + 1024, gs, sh, lane);
        for (int r = gw; r < NCTX; r += nw) norm_rows<1, false>(Pctx->ctx, (size_t)r, dst + (size_t)(NT + r) * DM, gs, sh, lane);
    }
}

constexpr int ACT_PITCH = 260;
__device__ __forceinline__ void dft_load_tile(const bf16_t* src, size_t row_stride, LAS unsigned char* act) {
    const int tid = threadIdx.x, chunk = tid & 31, r0 = tid >> 5;
#pragma unroll
    for (int i = 0; i < 8; ++i) { const int r = r0 + 16 * i; const u32x4 v = *(const u32x4*)(src + (size_t)r * row_stride + chunk * 8);
        LAS u32x2* d = (LAS u32x2*)(act + r * (ACT_PITCH * 2) + chunk * 16); d[0] = (u32x2){v.x, v.y}; d[1] = (u32x2){v.z, v.w}; }
}
__device__ __forceinline__ bf16x8 dft_gather(const LAS unsigned char* act, int kc, int fq, int ch) {
    const LAS bf16_t* p = (const LAS bf16_t*)act + (kc * 32 + fq * 8) * ACT_PITCH + ch;
    bf16x8 r;
#pragma unroll
    for (int i = 0; i < 8; ++i) r[i] = (short)p[i * ACT_PITCH];
    return r;
}
__device__ void dft_stage1(const Params& P, LAS unsigned char* lds) {
    const int tid = threadIdx.x, wid = tid >> 6, lane = tid & 63, fr = lane & 15, fq = lane >> 4;
    LAS unsigned char* d1c = lds; LAS unsigned char* d1s = lds + 34816; LAS unsigned char* act = lds + 69632;
    __syncthreads();
#pragma unroll
    for (int id = tid; id < 2 * 2048; id += 512) { const int mtx = id >> 11, r = (id >> 4) & 127, ch = id & 15;
        const u32x4 v = *(const u32x4*)(P.ws + (mtx ? WS_D1S : WS_D1C) + r * 256 + ch * 16);
        *(LAS u32x4*)((mtx ? d1s : d1c) + r * 272 + ch * 16) = v; }
    const bf16_t* pbuf = (const bf16_t*)(P.ws + WS_BIG + BIG_P);
    bf16_t* s1 = (bf16_t*)(P.ws + WS_BIG + BIG_S1);
    for (int u = blockIdx.x; u < NB * 64 * 2; u += gridDim.x) {
        const int half = u & 1, bb = (u >> 1) & 63, b = u >> 7;
        __syncthreads();
        dft_load_tile(pbuf + ((size_t)b * SEQ + bb) * PW + half * 256, (size_t)64 * PW, act);
        __syncthreads();
#pragma unroll 1
        for (int cti = 0; cti < 2; ++cti) {
            const int ct = wid * 2 + cti;
            bf16x8 af[4];
#pragma unroll
            for (int kc = 0; kc < 4; ++kc) af[kc] = dft_gather(act, kc, fq, ct * 16 + fr);
            const int chg = half * 256 + ct * 16 + fq * 4;
#pragma unroll 1
            for (int kt = 0; kt < 8; ++kt) {
                f32x4 aR = (f32x4){0.f, 0.f, 0.f, 0.f}, aI = (f32x4){0.f, 0.f, 0.f, 0.f};
#pragma unroll
                for (int kc = 0; kc < 4; ++kc) {
                    const bf16x8 bc = *(const LAS bf16x8*)(d1c + (kt * 16 + fr) * 272 + (kc * 32 + fq * 8) * 2);
                    const bf16x8 bs = *(const LAS bf16x8*)(d1s + (kt * 16 + fr) * 272 + (kc * 32 + fq * 8) * 2);
                    aR = __builtin_amdgcn_mfma_f32_16x16x32_bf16(af[kc], bc, aR, 0, 0, 0);
                    aI = __builtin_amdgcn_mfma_f32_16x16x32_bf16(af[kc], bs, aI, 0, 0, 0);
                }
                const int ka = kt * 16 + fr;
                float sph, cph; sincospif((float)((ka * bb) & 8191) * (1.0f / 4096.0f), &sph, &cph);
                cph *= (1.0f / 32.0f); sph *= (1.0f / 32.0f);
                float re[4], im[4];
#pragma unroll
                for (int j = 0; j < 4; ++j) { const float x = aR[j], y = aI[j]; const float r0 = x * cph + y * sph, i0 = y * cph - x * sph;
                    const bool isq = ((chg + j) & 127) > 64; re[j] = isq ? -i0 : r0; im[j] = isq ? r0 : i0; }
                bf16_t* d = s1 + ((((size_t)b * 128 + ka) * 64 + bb) * 2) * 512 + chg;
                *(u32x2*)d = (u32x2){cvt_pk_bf16(re[0], re[1]), cvt_pk_bf16(re[2], re[3])};
                *(u32x2*)(d + 512) = (u32x2){cvt_pk_bf16(im[0], im[1]), cvt_pk_bf16(im[2], im[3])};
            }
        }
    }
    __syncthreads();
}
__device__ void dft_stage2(const Params& P, LAS unsigned char* lds) {
    const int tid = threadIdx.x, wid = tid >> 6, lane = tid & 63, fr = lane & 15, fq = lane >> 4;
    LAS unsigned char* d2 = lds; LAS unsigned char* act = lds + 17408;
    __syncthreads();
#pragma unroll
    for (int id = tid; id < 1024; id += 512) { const int r = id >> 4, ch = id & 15; *(LAS u32x4*)(d2 + r * 272 + ch * 16) = *(const u32x4*)(P.ws + WS_D2 + r * 256 + ch * 16); }
    const bf16_t* s1 = (const bf16_t*)(P.ws + WS_BIG + BIG_S1);
    bf16_t* cat = (bf16_t*)(P.ws + WS_BIG + BIG_CAT);
    for (int u = blockIdx.x; u < NB * 128 * 2; u += gridDim.x) {
        const int half = u & 1, ka = (u >> 1) & 127, b = u >> 8;
        __syncthreads();
        dft_load_tile(s1 + (((size_t)b * 128 + ka) * 128) * 512 + half * 256, 512, act);
        __syncthreads();
#pragma unroll 1
        for (int cti = 0; cti < 2; ++cti) {
            const int ct = wid * 2 + cti;
            bf16x8 af[4];
#pragma unroll
            for (int kc = 0; kc < 4; ++kc) af[kc] = dft_gather(act, kc, fq, ct * 16 + fr);
            f32x4 acc[4];
#pragma unroll
            for (int kt = 0; kt < 4; ++kt) acc[kt] = (f32x4){0.f, 0.f, 0.f, 0.f};
#pragma unroll
            for (int kt = 0; kt < 4; ++kt)
#pragma unroll
                for (int kc = 0; kc < 4; ++kc) {
                    const bf16x8 bv = *(const LAS bf16x8*)(d2 + (kt * 16 + fr) * 272 + (kc * 32 + fq * 8) * 2);
                    acc[kt] = __builtin_amdgcn_mfma_f32_16x16x32_bf16(af[kc], bv, acc[kt], 0, 0, 0);
                }
#pragma unroll
            for (int kt = 0; kt < 4; ++kt) { const int kb = kt * 16 + fr; const size_t tok = (size_t)b * SEQ + ka + 128 * kb;
                *(u32x2*)(cat + tok * 1024 + half * 256 + ct * 16 + fq * 4) = (u32x2){cvt_pk_bf16(acc[kt][0], acc[kt][1]), cvt_pk_bf16(acc[kt][2], acc[kt][3])}; }
        }
    }
    __syncthreads();
}

constexpr int VP = 160;
__device__ void natten_phase(const Params& P, LAS unsigned char* lds) {
    const int tid = threadIdx.x, wid = __builtin_amdgcn_readfirstlane(tid >> 6), lane = tid & 63, fr = lane & 15, fq = lane >> 4;
    LAS unsigned char* vimg = lds;
    LAS float* rpbs = (LAS float*)(lds + 832 * VP);
    const bf16_t* pbuf = (const bf16_t*)(P.ws + WS_BIG + BIG_P);
    bf16_t* cat = (bf16_t*)(P.ws + WS_BIG + BIG_CAT);
    const int upb = (NB * 8 * 64 + gridDim.x - 1) / gridDim.x;
    int lastbh = -1;
    for (int u = blockIdx.x * upb; u < min((int)(blockIdx.x + 1) * upb, NB * 8 * 64); ++u) {
        const int rp = u & 63, h = (u >> 6) & 7, b = u >> 9;
        const bool newbh = ((u >> 6) != lastbh); lastbh = u >> 6;
        const int rs0 = min(max(2 * rp - 4, 0), 120), rs1 = min(max(2 * rp - 3, 0), 120), nrows = rs1 - rs0 + 8;
        __syncthreads();
        {
            u32x4 tv[13];
            const int ch = tid & 7, r0 = tid >> 3;
            const bf16_t* vw = pbuf + ((size_t)b * SEQ + rs0 * 64 + r0) * PW + 1536 + h * 64 + ch * 8;
            const bf16_t* vc = pbuf + ((size_t)NT + b * CTXL + r0) * PW + 1536 + h * 64 + ch * 8;
#pragma unroll
            for (int i = 0; i < 8; ++i) tv[i] = *(const u32x4*)(vw + (size_t)i * 64 * PW);
            if (nrows == 9) tv[8] = *(const u32x4*)(vw + (size_t)8 * 64 * PW);
            if (newbh) {
#pragma unroll
                for (int i = 0; i < 4; ++i) tv[9 + i] = *(const u32x4*)(vc + (size_t)i * 64 * PW); }
#pragma unroll
            for (int i = 0; i < 8; ++i) *(LAS u32x4*)(vimg + (r0 + 64 * i) * VP + ch * 16) = tv[i];
            if (nrows == 9) *(LAS u32x4*)(vimg + (r0 + 512) * VP + ch * 16) = tv[8];
            if (newbh) {
#pragma unroll
                for (int i = 0; i < 4; ++i) *(LAS u32x4*)(vimg + (576 + r0 + 64 * i) * VP + ch * 16) = tv[9 + i]; }
        }
        if (newbh && tid < 465) rpbs[tid] = P.rpb[h * 465 + tid] * 1.44269504f;
        __syncthreads();
        const int r = 2 * rp + (wid >> 2), qt = wid & 3, c0 = (qt == 0) ? 0 : (qt == 1 ? 8 : (qt == 2 ? 24 : 32));
        const int rs = min(max(r - 4, 0), 120);
        const size_t qtok = (size_t)b * SEQ + r * 64 + qt * 16 + fr;
        const unsigned lofs = (unsigned)(fr * PW + fq * 8) * 2u;
        const char* qbase = (const char*)(pbuf + ((size_t)b * SEQ + r * 64 + qt * 16) * PW + 512 + h * 64);
        const char* kbase = (const char*)(pbuf + ((size_t)b * SEQ + rs * 64 + c0) * PW + 1024 + h * 64);
        const char* cbase = (const char*)(pbuf + ((size_t)NT + b * CTXL) * PW + 1024 + h * 64);
        const bf16x8 q0 = *(const bf16x8*)(qbase + lofs);
        const bf16x8 q1 = *(const bf16x8*)(qbase + 64 + lofs);
        f32x4 s[32];
#pragma unroll
        for (int t = 0; t < 16; ++t) {
            const unsigned toff = (unsigned)(((t >> 1) * 64 + (t & 1) * 16) * PW * 2);
            const bf16x8 k0 = *(const bf16x8*)(kbase + toff + lofs);
            const bf16x8 k1 = *(const bf16x8*)(kbase + toff + 64 + lofs);
            f32x4 a = (f32x4){0.f, 0.f, 0.f, 0.f};
            a = __builtin_amdgcn_mfma_f32_16x16x32_bf16(k0, q0, a, 0, 0, 0);
            s[t] = __builtin_amdgcn_mfma_f32_16x16x32_bf16(k1, q1, a, 0, 0, 0);
        }
#pragma unroll
        for (int t = 0; t < 16; ++t) {
            const unsigned toff = (unsigned)(t * 16 * PW * 2);
            const bf16x8 k0 = *(const bf16x8*)(cbase + toff + lofs);
            const bf16x8 k1 = *(const bf16x8*)(cbase + toff + 64 + lofs);
            f32x4 a = (f32x4){0.f, 0.f, 0.f, 0.f};
            a = __builtin_amdgcn_mfma_f32_16x16x32_bf16(k0, q0, a, 0, 0, 0);
            s[16 + t] = __builtin_amdgcn_mfma_f32_16x16x32_bf16(k1, q1, a, 0, 0, 0);
        }
        const int cq = qt * 16 + fr, cst = min(max(cq - 8, 0), 48);
        const int vlo = cst - c0 - fq * 4;
        const LAS float* brow = rpbs + (rs - r + 7) * 31 + (15 + c0 + fq * 4 - cq);
        float mx = -1e30f;
#pragma unroll
        for (int t = 0; t < 16; ++t) {
#pragma unroll
            for (int j = 0; j < 4; ++j) { const int off = (t & 1) * 16 + j;
                const float v = ((unsigned)(off - vlo) < 16u) ? s[t][j] + brow[(t >> 1) * 31 + off] : -1e30f; s[t][j] = v; mx = fmaxf(mx, v); }
        }
#pragma unroll
        for (int t = 16; t < 32; ++t)
#pragma unroll
            for (int j = 0; j < 4; ++j) mx = fmaxf(mx, s[t][j]);
        mx = fmaxf(mx, __shfl_xor(mx, 16)); mx = fmaxf(mx, __shfl_xor(mx, 32));
        float sum = 0.f;
#pragma unroll
        for (int t = 0; t < 32; ++t)
#pragma unroll
            for (int j = 0; j < 4; ++j) { const float p = __builtin_amdgcn_exp2f(s[t][j] - mx); s[t][j] = p; sum += p; }
        sum += __shfl_xor(sum, 16); sum += __shfl_xor(sum, 32);
        f32x4 o[4];
#pragma unroll
        for (int dt = 0; dt < 4; ++dt) o[dt] = (f32x4){0.f, 0.f, 0.f, 0.f};
        const int trq = (lane >> 2) & 3, trp = lane & 3;
#pragma unroll
        for (int pi = 0; pi < 16; ++pi) {
            const int t0 = 2 * pi, t1 = 2 * pi + 1;
            int rb0, rb1;
            if (pi < 8) { rb0 = (rs + pi - rs0) * 64 + c0; rb1 = rb0 + 16; } else { rb0 = 576 + (t0 - 16) * 16; rb1 = rb0 + 16; }
            bf16x8 pf; { const unsigned a0 = cvt_pk_bf16(s[t0][0], s[t0][1]), a1 = cvt_pk_bf16(s[t0][2], s[t0][3]), a2 = cvt_pk_bf16(s[t1][0], s[t1][1]), a3 = cvt_pk_bf16(s[t1][2], s[t1][3]);
                u32x4 w = (u32x4){a0, a1, a2, a3}; pf = __builtin_bit_cast(bf16x8, w); }
#pragma unroll
            for (int dt = 0; dt < 4; ++dt) {
                const s16x4 v0 = __builtin_amdgcn_ds_read_tr16_b64_v4i16((LAS s16x4*)(vimg + (rb0 + fq * 4 + trq) * VP + (dt * 16 + trp * 4) * 2));
                const s16x4 v1 = __builtin_amdgcn_ds_read_tr16_b64_v4i16((LAS s16x4*)(vimg + (rb1 + fq * 4 + trq) * VP + (dt * 16 + trp * 4) * 2));
                bf16x8 vf; vf[0] = v0[0]; vf[1] = v0[1]; vf[2] = v0[2]; vf[3] = v0[3]; vf[4] = v1[0]; vf[5] = v1[1]; vf[6] = v1[2]; vf[7] = v1[3];
                o[dt] = __builtin_amdgcn_mfma_f32_16x16x32_bf16(vf, pf, o[dt], 0, 0, 0);
            }
        }
        const float inv = 1.0f / sum;
#pragma unroll
        for (int dt = 0; dt < 4; ++dt)
            *(u32x2*)(cat + qtok * 1024 + 512 + h * 64 + dt * 16 + fq * 4) = (u32x2){cvt_pk_bf16(o[dt][0] * inv, o[dt][1] * inv), cvt_pk_bf16(o[dt][2] * inv, o[dt][3] * inv)};
    }
    __syncthreads();
}

template <int HW>
__device__ __forceinline__ void pool_item(const bf16_t* u, bf16_t* pooled, int t, int chunk) {
    const int tl = t & (SEQ - 1);
    const bf16_t* base = u + (size_t)(t - tl) * DM + chunk * 8;
    float a[8];
#pragma unroll
    for (int i = 0; i < 8; ++i) a[i] = 0.f;
    u32x4 v[2 * HW];
#pragma unroll
    for (int d = 0; d < 2 * HW; ++d) { const int r = tl - HW + d, rc = min(max(r, 0), SEQ - 1); v[d] = *(const u32x4*)(base + (size_t)rc * DM); }
#pragma unroll
    for (int d = 0; d < 2 * HW; ++d) { const int r = tl - HW + d; const float w = (r >= 0 && r < SEQ) ? 1.0f : 0.0f;
        a[0] += w * bf_lo(v[d].x); a[1] += w * bf_hi(v[d].x); a[2] += w * bf_lo(v[d].y); a[3] += w * bf_hi(v[d].y); a[4] += w * bf_lo(v[d].z); a[5] += w * bf_hi(v[d].z); a[6] += w * bf_lo(v[d].w); a[7] += w * bf_hi(v[d].w); }
    const int lo = max(tl - HW, 0), hi = min(tl + HW, SEQ);
    const float ic = 1.0f / (float)(hi - lo);
    const u32x4 c = v[HW];
    u32x4 w; w.x = cvt_pk_bf16(a[0] * ic - bf_lo(c.x), a[1] * ic - bf_hi(c.x)); w.y = cvt_pk_bf16(a[2] * ic - bf_lo(c.y), a[3] * ic - bf_hi(c.y));
    w.z = cvt_pk_bf16(a[4] * ic - bf_lo(c.z), a[5] * ic - bf_hi(c.z)); w.w = cvt_pk_bf16(a[6] * ic - bf_lo(c.w), a[7] * ic - bf_hi(c.w));
    *(u32x4*)(pooled + (size_t)t * DM + chunk * 8) = w;
}
__device__ void pool_pass(const bf16_t* u, bf16_t* pooled) {
    const int lane = threadIdx.x & 63, gw = blockIdx.x * 8 + (threadIdx.x >> 6), nw = gridDim.x * 8;
    for (int wi = gw; wi < (NT / 2) * 4; wi += nw) {
        const int gi = wi & 3, t = (wi >> 2) * 2 + (lane >> 5), chunk = gi * 32 + (lane & 31);
        if (gi == 0) pool_item<1>(u, pooled, t, chunk); else if (gi == 1) pool_item<2>(u, pooled, t, chunk); else if (gi == 2) pool_item<4>(u, pooled, t, chunk); else pool_item<8>(u, pooled, t, chunk);
    }
}

template <int HW>
__device__ __forceinline__ void pool_from_lds(const LAS unsigned char* U, bf16_t* pooled, int t0, int tl0, int tbase, int chunk) {
#pragma unroll 2
    for (int i = 0; i < 8; ++i) {
        const int t = tbase + i, tl = tl0 + t;
        float a[8];
#pragma unroll
        for (int k = 0; k < 8; ++k) a[k] = 0.f;
#pragma unroll
        for (int d = 0; d < 2 * HW; ++d) { const int r = tl - HW + d; const float w = (r >= 0 && r < SEQ) ? 1.0f : 0.0f;
            const u32x4 v = *(const LAS u32x4*)(U + (t + 8 - HW + d) * 2048 + chunk * 16);
            a[0] += w * bf_lo(v.x); a[1] += w * bf_hi(v.x); a[2] += w * bf_lo(v.y); a[3] += w * bf_hi(v.y); a[4] += w * bf_lo(v.z); a[5] += w * bf_hi(v.z); a[6] += w * bf_lo(v.w); a[7] += w * bf_hi(v.w); }
        const int lo = max(tl - HW, 0), hi = min(tl + HW, SEQ);
        const float ic = 1.0f / (float)(hi - lo);
        const u32x4 c = *(const LAS u32x4*)(U + (t + 8) * 2048 + chunk * 16);
        u32x4 w; w.x = cvt_pk_bf16(a[0] * ic - bf_lo(c.x), a[1] * ic - bf_hi(c.x)); w.y = cvt_pk_bf16(a[2] * ic - bf_lo(c.y), a[3] * ic - bf_hi(c.y));
        w.z = cvt_pk_bf16(a[4] * ic - bf_lo(c.z), a[5] * ic - bf_hi(c.z)); w.w = cvt_pk_bf16(a[6] * ic - bf_lo(c.w), a[7] * ic - bf_hi(c.w));
        *(u32x4*)(pooled + (size_t)(t0 + t) * DM + chunk * 8) = w;
    }
}
__device__ void pool_norm_fused(const bf16_t* h, const float* gn, const float* mod, bf16_t* pooled, LAS unsigned char* lds) {
    int tid = threadIdx.x; asm volatile("" : "+v"(tid));
    const int wid = tid >> 6, lane = tid & 63;
    for (int ck = blockIdx.x; ck < NT / 32; ck += gridDim.x) {
        const int t0 = ck * 32, b = t0 >> 13, tl0 = t0 & (SEQ - 1);
        f32x4 gs[4], sh[4];
        load_mod_vecs(gn, mod + (size_t)b * NMOD, mod + (size_t)b * NMOD + 1024, gs, sh, lane);
        __syncthreads();
#pragma unroll 1
        for (int rr = 0; rr < 6; rr += 2) {
            f32x4 v[2][4]; float ss[2];
#pragma unroll
            for (int q = 0; q < 2; ++q) { const int row = wid * 6 + rr + q, tl = min(max(tl0 - 8 + row, 0), SEQ - 1);
#pragma unroll
                for (int j = 0; j < 2; ++j) ld8<true>(h, ((size_t)b * SEQ + tl) * DM + j * 512 + lane * 8, v[q][2 * j], v[q][2 * j + 1]); }
#pragma unroll
            for (int q = 0; q < 2; ++q) { ss[q] = 0.f;
#pragma unroll
                for (int i = 0; i < 4; ++i) ss[q] += v[q][i][0] * v[q][i][0] + v[q][i][1] * v[q][i][1] + v[q][i][2] * v[q][i][2] + v[q][i][3] * v[q][i][3]; }
#pragma unroll
            for (int o = 32; o >= 1; o >>= 1) { ss[0] += __shfl_xor(ss[0], o); ss[1] += __shfl_xor(ss[1], o); }
#pragma unroll
            for (int q = 0; q < 2; ++q) { const float rs = rsqrtf(ss[q] * (1.0f / 1024.0f) + 1e-6f); const int row = wid * 6 + rr + q;
#pragma unroll
                for (int j = 0; j < 2; ++j) { const f32x4 a = v[q][2 * j] * rs * gs[2 * j] + sh[2 * j], c = v[q][2 * j + 1] * rs * gs[2 * j + 1] + sh[2 * j + 1];
                    u32x4 w; w.x = cvt_pk_bf16(a[0], a[1]); w.y = cvt_pk_bf16(a[2], a[3]); w.z = cvt_pk_bf16(c[0], c[1]); w.w = cvt_pk_bf16(c[2], c[3]);
                    *(LAS u32x4*)(lds + row * 2048 + (j * 512 + lane * 8) * 2) = w; } }
        }
        __syncthreads();
        const int g = wid & 3, chunk = g * 32 + (lane & 31), tbase = (wid >> 2) * 16 + (lane >> 5) * 8;
        if (g == 0) pool_from_lds<1>(lds, pooled, t0, tl0, tbase, chunk); else if (g == 1) pool_from_lds<2>(lds, pooled, t0, tl0, tbase, chunk);
        else if (g == 2) pool_from_lds<4>(lds, pooled, t0, tl0, tbase, chunk); else pool_from_lds<8>(lds, pooled, t0, tl0, tbase, chunk);
    }
    __syncthreads();
}

#define XB_TMO      128
#define XB_XCNT(j)  (256  + 64 * (j))
#define XB_XSUB(j)  (1280 + 64 * (j))
#define XB_XGEN(j)  (2304 + 64 * (j))
#define XB_TOP      3328
#define XB_TOPGEN   3392
#define XCD_BAR_WORDS 3456
#define XB_SPIN_CAP (1u << 18)
__device__ __forceinline__ unsigned xb_ld(unsigned* p)              { return __hip_atomic_load(p, __ATOMIC_RELAXED, __HIP_MEMORY_SCOPE_AGENT); }
__device__ __forceinline__ unsigned xb_add(unsigned* p, unsigned v) { return __hip_atomic_fetch_add(p, v, __ATOMIC_RELAXED, __HIP_MEMORY_SCOPE_AGENT); }
__device__ __forceinline__ unsigned xb_xcc_id() { return (unsigned)__builtin_amdgcn_s_getreg((3 << 11) | 20) & 0xFu; }
#define XB_SPIN(cond, bar) do { unsigned _sp = 0; while (cond) { __builtin_amdgcn_s_sleep(1); \
    if ((++_sp & 255u) == 0u) { if (xb_ld(&(bar)[XB_TMO])) break; if (_sp > XB_SPIN_CAP) { atomicAdd(&(bar)[XB_TMO], 1u); break; } } } } while (0)
struct XcdBarrier { unsigned* bar; unsigned x; volatile LAS unsigned* st; };
__device__ __forceinline__ XcdBarrier xcd_barrier_post(unsigned* bar, volatile LAS unsigned* st) {
    XcdBarrier b; b.bar = bar; b.x = xb_xcc_id(); b.st = st;
    if (threadIdx.x == 0) (void)xb_add(&bar[XB_XCNT(b.x)], 1u);
    return b;
}
__device__ __forceinline__ void xcd_barrier_complete(unsigned* bar, unsigned x, unsigned& nloc, unsigned& nx) {
    const unsigned G = gridDim.x * gridDim.y * gridDim.z;
    unsigned sum, cnt, mine, sp = 0u;
    for (;;) {
        sum = 0u; cnt = 0u; mine = 0u;
#pragma unroll
        for (unsigned j = 0; j < 16; ++j) { const unsigned c = xb_ld(&bar[XB_XCNT(j)]); sum += c; cnt += (c > 0u) ? 1u : 0u; mine = (j == x) ? c : mine; }
        if (sum == G) break;
        __builtin_amdgcn_s_sleep(1);
        if ((++sp & 255u) == 0u) { if (xb_ld(&bar[XB_TMO])) break; if (sp > XB_SPIN_CAP) { atomicAdd(&bar[XB_TMO], 1u); break; } }
    }
    nloc = mine > 0u ? mine : 1u; nx = cnt > 0u ? cnt : 1u;
}
__device__ __forceinline__ void xcd_barrier(const XcdBarrier& b) {
    asm volatile("s_waitcnt vmcnt(0)" ::: "memory");
    __syncthreads();
    if (threadIdx.x == 0) {
        unsigned* bar = b.bar;
        __builtin_amdgcn_s_waitcnt(0);
        unsigned nloc = b.st[0], nx = b.st[1];
        if (nloc == 0u) { xcd_barrier_complete(bar, b.x, nloc, nx); b.st[0] = nloc; b.st[1] = nx; }
        const unsigned old = xb_add(&bar[XB_XSUB(b.x)], 1u);
        const unsigned gen = old / nloc;
        if (old + 1u == (gen + 1u) * nloc) {
            __builtin_amdgcn_fence(__ATOMIC_RELEASE, "agent");
            asm volatile("s_waitcnt vmcnt(0)" ::: "memory");
            const unsigned og = xb_add(&bar[XB_TOP], 1u);
            const unsigned tg = og / nx;
            if (og + 1u == (tg + 1u) * nx) xb_add(&bar[XB_TOPGEN], 1u);
            else XB_SPIN(xb_ld(&bar[XB_TOPGEN]) == tg, bar);
            __builtin_amdgcn_fence(__ATOMIC_ACQUIRE, "agent");
            xb_add(&bar[XB_XGEN(b.x)], 1u);
            asm volatile("s_waitcnt vmcnt(0)" ::: "memory");
        } else {
            XB_SPIN(xb_ld(&bar[XB_XGEN(b.x)]) == gen, bar);
            __builtin_amdgcn_fence(__ATOMIC_ACQUIRE, "agent");
            asm volatile("s_waitcnt vmcnt(0)" ::: "memory");
        }
    }
    __syncthreads();
}

__global__ void __launch_bounds__(512, 2) fwd_megakernel(Params P) {
    extern __shared__ __attribute__((aligned(16))) unsigned char shm[];
    LAS unsigned char* lds = (LAS unsigned char*)shm;
    cg::grid_group grid = cg::this_grid();
    volatile LAS unsigned* xst = (volatile LAS unsigned*)(lds + LDS_BYTES - 16);
    if (threadIdx.x == 0) { xst[0] = 0u; xst[1] = 0u; }
    __syncthreads();
    const XcdBarrier xb = xcd_barrier_post((unsigned*)(P.ws + WS_CTL), xst);
#define GSYNC(n) xcd_barrier(xb)
    unsigned char* ws = P.ws;
    const float* mod0 = (const float*)(ws + WS_MOD0); const float* mod1 = (const float*)(ws + WS_MOD1);
    bf16_t* ubuf = (bf16_t*)(ws + WS_U);
    bf16_t* pbuf = (bf16_t*)(ws + WS_BIG + BIG_P);
    bf16_t* cat = (bf16_t*)(ws + WS_BIG + BIG_CAT);
    bf16_t* abuf = (bf16_t*)(ws + WS_BIG + BIG_A);
    bf16_t* pooled = (bf16_t*)(ws + WS_BIG + BIG_POOL);

    phase0(P, lds);
    asm volatile("s_waitcnt vmcnt(0)" ::: "memory");
    grid.sync();
    __builtin_amdgcn_fence(__ATOMIC_ACQUIRE, "agent");
    asm volatile("s_waitcnt vmcnt(0)" ::: "memory");
    bf16_t* hres = (bf16_t*)(ws + WS_H);
    norm_pass<false>(P.x, ubuf, P.norm1_g, mod0, 0, &P, hres);
    GSYNC(2);
    { Gemm g{ubuf, (const bf16_t*)(ws + WS_WIN), DM, DM, DM, (NT + NCTX) / 256, PW / 256, 0, 0, 0}; EpiProj E{pbuf, P.q_g, P.k_g}; gemm_phase(lds, g, E); }
    GSYNC(3);
    natten_phase(P, lds);
    dft_stage1(P, lds);
    GSYNC(4);
    dft_stage2(P, lds);
    GSYNC(5);
    { Gemm g{cat, (const bf16_t*)(ws + WS_WOUT), DM, DM, DM, NT / 256, DM / 256, 0, 0, 0}; EpiResT<true, true> E{hres, hres, mod0 + 2048, nullptr}; gemm_phase(lds, g, E); }
    GSYNC(6);
    norm_pass<true>(hres, ubuf, P.norm2_g, mod0, 1, nullptr);
    GSYNC(7);
    { Gemm g{ubuf, (const bf16_t*)(ws + WS_W1), DM, DM, DM, NT / 256, HID / 256, 0, 0, 0}; EpiAct E{abuf, HID}; gemm_phase(lds, g, E); }
    GSYNC(8);
    { Gemm g{abuf, (const bf16_t*)(ws + WS_W2), HID, HID, HID, NT / 256, DM / 256, 0, HID / 64, HID / 64}; EpiResT<true, true> E{hres, hres, mod0 + 5120, nullptr}; gemm_phase(lds, g, E); }
    GSYNC(9);
    pool_norm_fused(hres, P.norm1_g + DM, mod1, pooled, lds);
    GSYNC(11);
    { Gemm g{pooled, (const bf16_t*)(ws + WS_WPOOL), DM, 256, 256, NT / 256, 4, 512, 0, 0}; EpiResT<true, true> E{hres, hres, mod1 + 2048, P.pool_scale}; gemm_phase(lds, g, E); }
    GSYNC(12);
    norm_pass<true>(hres, ubuf, P.norm2_g + DM, mod1, 1, nullptr);
    GSYNC(13);
    { Gemm g{ubuf, (const bf16_t*)(ws + WS_W1) + (size_t)HID * DM, DM, DM, DM, NT / 256, HID / 256, 0, 0, 0}; EpiAct E{abuf, HID}; gemm_phase(lds, g, E); }
    GSYNC(14);
    { Gemm g{abuf, (const bf16_t*)(ws + WS_W2) + (size_t)DM * HID, HID, HID, HID, NT / 256, DM / 256, 0, HID / 64, HID / 64}; EpiResT<true, false> E{hres, P.out, mod1 + 5120, nullptr}; gemm_phase(lds, g, E); }
}

extern "C" void kernel_launch(void* const* d_in, const int* in_sizes, int n_in, void* d_out, int out_size, void* d_ws, size_t ws_size, hipStream_t stream) {
    static int grid_blocks = 0;
    if (grid_blocks == 0) {
        if (n_in != 18 || out_size != NT * DM || ws_size < WS_END) { fprintf(stderr, "kernel_launch: unexpected shapes (n_in %d out %d ws %zu need %zu)\n", n_in, out_size, ws_size, (size_t)WS_END); grid_blocks = -1; return; }
        int dev = 0, cus = 0, per_cu = 0;
        (void)hipGetDevice(&dev);
        (void)hipDeviceGetAttribute(&cus, hipDeviceAttributeMultiprocessorCount, dev);
        if (hipFuncSetAttribute((const void*)fwd_megakernel, hipFuncAttributeMaxDynamicSharedMemorySize, LDS_BYTES) != hipSuccess) { fprintf(stderr, "kernel_launch: hipFuncSetAttribute failed\n"); grid_blocks = -1; return; }
        if (hipOccupancyMaxActiveBlocksPerMultiprocessor(&per_cu, (const void*)fwd_megakernel, 512, LDS_BYTES) != hipSuccess || per_cu < 1) { fprintf(stderr, "kernel_launch: occupancy query failed (%d)\n", per_cu); (void)hipGetLastError(); per_cu = 1; }
        grid_blocks = cus * 1;
        (void)per_cu;
    }
    if (grid_blocks < 0) return;
    Params p{};
    p.x = (const float*)d_in[0]; p.c = (const float*)d_in[1]; p.ctx = (const float*)d_in[2]; p.c_ctx = (const float*)d_in[3]; p.w_mod = (const float*)d_in[4]; p.b_mod = (const float*)d_in[5];
    p.norm1_g = (const float*)d_in[6]; p.norm2_g = (const float*)d_in[7]; p.w_in = (const float*)d_in[8]; p.w_four = (const float*)d_in[9]; p.q_g = (const float*)d_in[10]; p.k_g = (const float*)d_in[11];
    p.rpb = (const float*)d_in[12]; p.w_out = (const float*)d_in[13]; p.w_pool = (const float*)d_in[14]; p.pool_scale = (const float*)d_in[15]; p.w_mlp1 = (const float*)d_in[16]; p.w_mlp2 = (const float*)d_in[17];
    p.out = (float*)d_out; p.ws = (unsigned char*)d_ws;
    if (hipMemsetAsync((char*)d_ws + WS_CTL, 0, 16384, stream) != hipSuccess) { fprintf(stderr, "kernel_launch: memset failed\n"); return; }
    void* args[] = {&p};
    hipError_t e = hipLaunchCooperativeKernel((const void*)fwd_megakernel, dim3(grid_blocks), dim3(512), args, LDS_BYTES, stream);
    if (e != hipSuccess) fprintf(stderr, "kernel_launch: cooperative launch failed: %s (grid %d)\n", hipGetErrorString(e), grid_blocks);
}
```

```cpp
#include <hip/hip_runtime.h>
#include <hip/hip_cooperative_groups.h>
#include <cstdio>
namespace cg = cooperative_groups;

#define LAS __attribute__((address_space(3)))
typedef unsigned short bf16_t;
typedef short bf16x8 __attribute__((ext_vector_type(8)));
typedef short s16x4 __attribute__((ext_vector_type(4)));
typedef float f32x4 __attribute__((ext_vector_type(4)));
typedef unsigned u32x4 __attribute__((ext_vector_type(4)));
typedef unsigned u32x2 __attribute__((ext_vector_type(2)));

constexpr int DM = 1024, NB = 4, SEQ = 8192, NT = NB * SEQ, CTXL = 256, NCTX = NB * CTXL, HID = 4096, NMOD = 6 * DM;
constexpr int PW = 2048;
constexpr int LDS_BYTES = 139264;

constexpr size_t al256(size_t x) { return (x + 255) & ~(size_t)255; }
constexpr size_t WS_CTL = 0;
constexpr size_t WS_MOD0 = 16384;
constexpr size_t WS_MOD1 = WS_MOD0 + al256((size_t)NB * NMOD * 4);
constexpr size_t WS_MODC = WS_MOD1 + al256((size_t)NB * NMOD * 4);
constexpr size_t WS_WIN = WS_MODC + al256(2048 * 4);
constexpr size_t WS_WOUT = WS_WIN + (size_t)PW * DM * 2;
constexpr size_t WS_W1 = WS_WOUT + (size_t)DM * DM * 2;
constexpr size_t WS_W2 = WS_W1 + (size_t)2 * HID * DM * 2;
constexpr size_t WS_WPOOL = WS_W2 + (size_t)2 * HID * DM * 2;
constexpr size_t WS_D1C = WS_WPOOL + (size_t)DM * 256 * 2;
constexpr size_t WS_D1S = WS_D1C + 128 * 128 * 2;
constexpr size_t WS_D2 = WS_D1S + 128 * 128 * 2;
constexpr size_t WS_U = WS_D2 + 64 * 128 * 2;
constexpr size_t WS_BIG = WS_U + (size_t)(NT + NCTX) * DM * 2;
constexpr size_t BIG_P = 0;
constexpr size_t BIG_S1 = BIG_P + (size_t)(NT + NCTX) * PW * 2;
constexpr size_t BIG_CAT = BIG_S1 + (size_t)NT * 1024 * 2;
constexpr size_t BIG_END = BIG_CAT + (size_t)NT * 1024 * 2;
constexpr size_t BIG_A = 0;
constexpr size_t BIG_POOL = 0;
constexpr size_t BIG_SIZE = BIG_END > (size_t)NT * HID * 2 ? BIG_END : (size_t)NT * HID * 2;
constexpr size_t WS_H = WS_BIG + BIG_SIZE;
constexpr size_t WS_END = WS_H + (size_t)NT * DM * 2;

struct Params {
    const float *x, *c, *ctx, *c_ctx, *w_mod, *b_mod, *norm1_g, *norm2_g, *w_in, *w_four, *q_g, *k_g, *rpb, *w_out, *w_pool, *pool_scale, *w_mlp1, *w_mlp2;
    float* out; unsigned char* ws;
};

typedef float f32x2 __attribute__((ext_vector_type(2)));
typedef __bf16 bf16x2v __attribute__((ext_vector_type(2)));
__device__ __forceinline__ unsigned cvt_pk_bf16(float lo, float hi) { const f32x2 f = {lo, hi}; const bf16x2v b = __builtin_convertvector(f, bf16x2v); return __builtin_bit_cast(unsigned, b); }
__device__ __forceinline__ float bf_lo(unsigned u) { return __uint_as_float(u << 16); }
__device__ __forceinline__ float bf_hi(unsigned u) { return __uint_as_float(u & 0xffff0000u); }
template <bool BF> __device__ __forceinline__ f32x4 ld4(const void* base, size_t idx) {
    if (BF) { const u32x2 v = *(const u32x2*)((const bf16_t*)base + idx); return (f32x4){bf_lo(v.x), bf_hi(v.x), bf_lo(v.y), bf_hi(v.y)}; }
    else return *(const f32x4*)((const float*)base + idx);
}
template <bool BF> __device__ __forceinline__ void st4(void* base, size_t idx, const f32x4 v) {
    if (BF) *(u32x2*)((bf16_t*)base + idx) = (u32x2){cvt_pk_bf16(v[0], v[1]), cvt_pk_bf16(v[2], v[3])};
    else *(f32x4*)((float*)base + idx) = v;
}
template <bool BF> __device__ __forceinline__ void ld8(const void* base, size_t idx, f32x4& a, f32x4& b) {
    if (BF) { const u32x4 v = *(const u32x4*)((const bf16_t*)base + idx); a = (f32x4){bf_lo(v.x), bf_hi(v.x), bf_lo(v.y), bf_hi(v.y)}; b = (f32x4){bf_lo(v.z), bf_hi(v.z), bf_lo(v.w), bf_hi(v.w)}; }
    else { a = __builtin_nontemporal_load((const f32x4*)((const float*)base + idx)); b = __builtin_nontemporal_load((const f32x4*)((const float*)base + idx + 4)); }
}
template <bool BF> __device__ __forceinline__ void st8(void* base, size_t idx, const f32x4 a, const f32x4 b) {
    if (BF) { u32x4 w; w.x = cvt_pk_bf16(a[0], a[1]); w.y = cvt_pk_bf16(a[2], a[3]); w.z = cvt_pk_bf16(b[0], b[1]); w.w = cvt_pk_bf16(b[2], b[3]); *(u32x4*)((bf16_t*)base + idx) = w; }
    else { __builtin_nontemporal_store(a, (f32x4*)((float*)base + idx)); __builtin_nontemporal_store(b, (f32x4*)((float*)base + idx + 4)); }
}
__device__ __forceinline__ int phys_row(int n, int mode) {
    const int L = n & 255, wc = L >> 6, bj = (L >> 5) & 1, j = L & 3;
    const int fq = mode ? ((L >> 2) & 3) : ((L >> 3) & 3), nn = mode ? ((L >> 4) & 1) : ((L >> 2) & 1);
    return (n & ~255) + 128 * bj + 32 * wc + 16 * nn + 4 * fq + j;
}

constexpr int BM = 256, BK = 64, HALF = 128, HTB = HALF * BK * 2, NXCD = 8, WGM = 8;
__device__ __forceinline__ int lds_byte(int r, int c) { const int st = (r >> 4) * 2 + (c >> 5), rr = r & 15, cc = c & 31, ob = rr * 64 + cc * 2; return st * 1024 + (ob ^ (((ob >> 9) & 1) << 5)); }
__device__ __forceinline__ void stage_rc(int b, int& R, int& C) { const int st = b / 1024, sb = b % 1024, swz = sb ^ (((sb >> 9) & 1) << 5); R = (st >> 1) * 16 + swz / 64; C = (st & 1) * 32 + (swz % 64) / 2; }
struct Unit { int pm, pn; };
struct Gemm { const bf16_t* A; const bf16_t* Bt; int lda, ldb, K, nM, nN, a_pn_bytes, a_blk, b_blk; };
__device__ __forceinline__ size_t blk_off(int row, int col, int nkt) { return ((size_t)(row >> 7) * nkt + (col >> 6)) * 16384 + lds_byte(row & 127, col & 63); }
struct StaticOrder {
    int nM, nN, nwg, G, c;
    __device__ void init(int nM_, int nN_, int G_, int c_) { nM = nM_; nN = nN_; nwg = nM * nN; G = G_; c = c_; }
    __device__ bool next(int i, Unit& u) const {
        const long L = (long)i * G + c; if (L >= nwg) return false;
        int wgid = (int)L; { const int q = nwg / NXCD, r = nwg % NXCD, xcd = wgid % NXCD, off = wgid / NXCD; wgid = (xcd < r ? xcd * (q + 1) : r * (q + 1) + (xcd - r) * q) + off; }
        const int nig = WGM * nN, gid = wgid / nig, fm = gid * WGM, gsz = (nM - fm) < WGM ? (nM - fm) : WGM;
        u.pm = fm + ((wgid % nig) % gsz); u.pn = (wgid % nig) / gsz; return true;
    }
};

template <class Epi>
__device__ __forceinline__ void gemm_phase(LAS unsigned char* lds, const Gemm g, const Epi& E) {
    const int tid = threadIdx.x, wid = __builtin_amdgcn_readfirstlane(tid >> 6), lane = tid & 63, wr = wid >> 2, wc = wid & 3, fr = lane & 15, fq = lane >> 4;
    const int K = g.K, nt = K / BK;
    StaticOrder S; S.init(g.nM, g.nN, (int)gridDim.x, (int)blockIdx.x);
    unsigned voffA[2], voffB[2];
#pragma unroll
    for (int i = 0; i < 2; ++i) { int R, C; stage_rc(tid * 16 + i * 8192, R, C); voffA[i] = g.a_blk ? (unsigned)(tid * 16 + i * 8192) : (unsigned)(R * g.lda + C) * 2u; voffB[i] = g.b_blk ? (unsigned)(tid * 16 + i * 8192) : (unsigned)(R * g.ldb + C) * 2u; }
    const size_t kstepA = g.a_blk ? (size_t)16384 : (size_t)(BK * 2), kstepB = g.b_blk ? (size_t)16384 : (size_t)(BK * 2);
    const size_t hstepA = g.a_blk ? (size_t)g.a_blk * 16384 : (size_t)HALF * g.lda * 2, hstepB = g.b_blk ? (size_t)g.b_blk * 16384 : (size_t)HALF * g.ldb * 2;
    const size_t tstepA = 2 * hstepA, tstepB = 2 * hstepB;
    const unsigned ldsw = (unsigned)wid * 1024u;
    const int aoff = lds_byte(wr * 64 + fr, fq * 8), boff = lds_byte(wc * 32 + fr, fq * 8);
#define G_SA(b, h) (((b) * 2 + (h)) * HTB)
#define G_SB(b, h) ((4 + (b) * 2 + (h)) * HTB)
#define G_STAGE(bufoff, gbase, voff) do { _Pragma("unroll") for (int _i = 0; _i < 2; ++_i) \
        __builtin_amdgcn_global_load_lds((const unsigned*)((const char*)(gbase) + (voff)[_i]), (LAS unsigned*)(lds + (bufoff) + ldsw + _i * 8192), 16, 0, 0); } while (0)
#define G_LDA(dst, b, h) do { _Pragma("unroll") for (int m = 0; m < 4; ++m) _Pragma("unroll") for (int k = 0; k < 2; ++k) dst[m][k] = *(const LAS bf16x8*)(lds + G_SA(b, h) + aoff + m * 2048 + k * 1024); } while (0)
#define G_LDB(dst, b, h) do { _Pragma("unroll") for (int n = 0; n < 2; ++n) _Pragma("unroll") for (int k = 0; k < 2; ++k) dst[n][k] = *(const LAS bf16x8*)(lds + G_SB(b, h) + boff + n * 2048 + k * 1024); } while (0)
#define G_MMA(ai, bj, At, Bt) do { __builtin_amdgcn_s_setprio(1); _Pragma("unroll") for (int m = 0; m < 4; ++m) _Pragma("unroll") for (int n = 0; n < 2; ++n) _Pragma("unroll") for (int k = 0; k < 2; ++k) \
        acc[ai][bj][m][n] = __builtin_amdgcn_mfma_f32_16x16x32_bf16(Bt[n][k], At[m][k], acc[ai][bj][m][n], 0, 0, 0); __builtin_amdgcn_s_setprio(0); } while (0)
#define G_WAIT_V(n) asm volatile("s_waitcnt vmcnt(" #n ")" ::: "memory")
#define G_WAIT_L(n) asm volatile("s_waitcnt lgkmcnt(" #n ")" ::: "memory")
#define G_BAR __builtin_amdgcn_s_barrier()
#define G_SCHED __builtin_amdgcn_sched_barrier(0)
    Unit cur, nxt; int ui = 0;
    if (!S.next(0, cur)) return;
    f32x4 acc[2][2][4][2];
#pragma unroll
    for (int a = 0; a < 2; ++a)
#pragma unroll
        for (int b = 0; b < 2; ++b)
#pragma unroll
            for (int m = 0; m < 4; ++m)
#pragma unroll
                for (int n = 0; n < 2; ++n) acc[a][b][m][n] = (f32x4){0.f, 0.f, 0.f, 0.f};
    bf16x8 At[4][2], B0[2][2], B1[2][2];
    const char* cA = (const char*)g.A + (size_t)cur.pm * tstepA + (size_t)cur.pn * g.a_pn_bytes; const char* cB = (const char*)g.Bt + (size_t)cur.pn * tstepB;
    G_STAGE(G_SB(0, 0), cB, voffB); G_STAGE(G_SA(0, 0), cA, voffA); G_STAGE(G_SB(0, 1), cB + hstepB, voffB); G_STAGE(G_SA(0, 1), cA + hstepA, voffA);
    if (wr == 1) G_BAR;
    G_WAIT_V(4); G_BAR;
    G_STAGE(G_SB(1, 0), cB + kstepB, voffB); G_STAGE(G_SA(1, 0), cA + kstepA, voffA); G_STAGE(G_SB(1, 1), cB + hstepB + kstepB, voffB);
    G_WAIT_V(6); G_BAR;
    for (;;) {
        const bool has_next = S.next(ui + 1, nxt);
        const char* nA = has_next ? (const char*)g.A + (size_t)nxt.pm * tstepA + (size_t)nxt.pn * g.a_pn_bytes : cA; const char* nB = has_next ? (const char*)g.Bt + (size_t)nxt.pn * tstepB : cB;
        for (int t = 0; t < nt; t += 2) {
            const bool last = (t == nt - 2);
            const char* a1 = cA + (size_t)(t + 1) * kstepA;
            const char* a2 = last ? nA : cA + (size_t)(t + 2) * kstepA; const char* b2 = last ? nB : cB + (size_t)(t + 2) * kstepB;
            const char* a3 = a2 + kstepA; const char* b3 = b2 + kstepB;
            G_LDB(B0, 0, 0); G_SCHED; G_LDA(At, 0, 0); G_STAGE(G_SA(1, 1), a1 + hstepA, voffA);
            G_WAIT_L(8); G_BAR; G_WAIT_L(0); G_MMA(0, 0, At, B0); G_BAR; G_SCHED;
            G_LDB(B1, 0, 1); G_STAGE(G_SB(0, 0), b2, voffB);
            G_BAR; G_WAIT_L(0); G_MMA(0, 1, At, B1); G_BAR;
            G_LDA(At, 0, 1); G_STAGE(G_SA(0, 0), a2, voffA);
            G_BAR; G_WAIT_L(0); G_MMA(1, 0, At, B0); G_BAR; G_SCHED;
            G_STAGE(G_SB(0, 1), b2 + hstepB, voffB);
            G_WAIT_V(6); G_BAR; G_MMA(1, 1, At, B1); G_BAR;
            G_LDB(B0, 1, 0); G_SCHED; G_LDA(At, 1, 0); G_STAGE(G_SA(0, 1), a2 + hstepA, voffA);
            G_WAIT_L(8); G_BAR; G_WAIT_L(0); G_MMA(0, 0, At, B0); G_BAR; G_SCHED;
            G_LDB(B1, 1, 1); G_STAGE(G_SB(1, 0), b3, voffB);
            G_BAR; G_WAIT_L(0); G_MMA(0, 1, At, B1); G_BAR;
            G_LDA(At, 1, 1); G_STAGE(G_SA(1, 0), a3, voffA);
            G_BAR; G_WAIT_L(0); G_MMA(1, 0, At, B0); G_BAR; G_SCHED;
            G_STAGE(G_SB(1, 1), b3 + hstepB, voffB);
            G_WAIT_V(6); G_BAR; G_MMA(1, 1, At, B1); G_BAR;
        }
        E(acc, cur, wr, wc, fr, fq);
        if (!has_next) break;
#pragma unroll
        for (int a = 0; a < 2; ++a)
#pragma unroll
            for (int b = 0; b < 2; ++b)
#pragma unroll
                for (int m = 0; m < 4; ++m)
#pragma unroll
                    for (int n = 0; n < 2; ++n) acc[a][b][m][n] = (f32x4){0.f, 0.f, 0.f, 0.f};
        cur = nxt; cA = nA; cB = nB; ++ui;
    }
    G_WAIT_V(0);
    if (wr == 0) G_BAR;
    G_BAR;
#undef G_SA
#undef G_SB
#undef G_STAGE
#undef G_LDA
#undef G_LDB
#undef G_MMA
#undef G_WAIT_V
#undef G_WAIT_L
#undef G_BAR
#undef G_SCHED
}

__device__ __forceinline__ void store16_bf16(bf16_t* dst, const float (&v)[16]) {
    u32x4 w0, w1;
    w0.x = cvt_pk_bf16(v[0], v[1]); w0.y = cvt_pk_bf16(v[2], v[3]); w0.z = cvt_pk_bf16(v[4], v[5]); w0.w = cvt_pk_bf16(v[6], v[7]);
    w1.x = cvt_pk_bf16(v[8], v[9]); w1.y = cvt_pk_bf16(v[10], v[11]); w1.z = cvt_pk_bf16(v[12], v[13]); w1.w = cvt_pk_bf16(v[14], v[15]);
    *(u32x4*)dst = w0; *(u32x4*)(dst + 8) = w1;
}
__device__ __forceinline__ void store8_bf16(bf16_t* dst, const f32x4 a, const f32x4 b) {
    u32x4 w; w.x = cvt_pk_bf16(a[0], a[1]); w.y = cvt_pk_bf16(a[2], a[3]); w.z = cvt_pk_bf16(b[0], b[1]); w.w = cvt_pk_bf16(b[2], b[3]);
    *(u32x4*)dst = w;
}
__device__ __forceinline__ void store8_bf16_nt(bf16_t* dst, const f32x4 a, const f32x4 b) {
    u32x4 w; w.x = cvt_pk_bf16(a[0], a[1]); w.y = cvt_pk_bf16(a[2], a[3]); w.z = cvt_pk_bf16(b[0], b[1]); w.w = cvt_pk_bf16(b[2], b[3]);
    __builtin_nontemporal_store(w, (u32x4*)dst);
}
struct EpiProj {
    bf16_t* P; const float* qg; const float* kg;
    __device__ __forceinline__ void operator()(const f32x4 (&acc)[2][2][4][2], const Unit& u, int wr, int wc, int fr, int fq) const {
        const int row0 = u.pm * BM + wr * 64 + fr, col0 = u.pn * BM + wc * 64 + fq * 8;
        const bool hn = (u.pn >= 2 && u.pn < 6);
        const float qs = (u.pn < 4) ? 0.18033688011112042f : 1.0f;
        f32x4 gv[2][2];
        if (hn) { const float* gp = (u.pn < 4 ? qg : kg) + fq * 8;
#pragma unroll
            for (int bj = 0; bj < 2; ++bj)
#pragma unroll
                for (int n = 0; n < 2; ++n) gv[bj][n] = *(const f32x4*)(gp + 32 * bj + 4 * n); }
#pragma unroll
        for (int ai = 0; ai < 2; ++ai)
#pragma unroll
            for (int m = 0; m < 4; ++m) {
                f32x4 v[2][2];
#pragma unroll
                for (int bj = 0; bj < 2; ++bj)
#pragma unroll
                    for (int n = 0; n < 2; ++n) v[bj][n] = acc[ai][bj][m][n];
                if (hn) {
                    float ss = 0.f;
#pragma unroll
                    for (int bj = 0; bj < 2; ++bj)
#pragma unroll
                        for (int n = 0; n < 2; ++n) ss += v[bj][n][0] * v[bj][n][0] + v[bj][n][1] * v[bj][n][1] + v[bj][n][2] * v[bj][n][2] + v[bj][n][3] * v[bj][n][3];
                    ss += __shfl_xor(ss, 16); ss += __shfl_xor(ss, 32);
                    const float rs = rsqrtf(ss * (1.0f / 64.0f) + 1e-6f);
#pragma unroll
                    for (int bj = 0; bj < 2; ++bj)
#pragma unroll
                        for (int n = 0; n < 2; ++n) v[bj][n] = v[bj][n] * (rs * qs) * gv[bj][n];
                }
                bf16_t* dst = P + (size_t)(row0 + ai * HALF + m * 16) * PW + col0;
                store8_bf16(dst, v[0][0], v[0][1]); store8_bf16(dst + 32, v[1][0], v[1][1]);
            }
    }
};
struct EpiAct {
    bf16_t* O; int ldo;
    __device__ __forceinline__ void operator()(const f32x4 (&acc)[2][2][4][2], const Unit& u, int wr, int wc, int fr, int fq) const {
        const int row0 = u.pm * BM + wr * 64 + fr, col0 = u.pn * BM + wc * 64 + fq * 8;
#pragma unroll
        for (int ai = 0; ai < 2; ++ai)
#pragma unroll
            for (int m = 0; m < 4; ++m) {
                const int row = row0 + ai * HALF + m * 16;
#pragma unroll
                for (int bj = 0; bj < 2; ++bj) { f32x4 a = acc[ai][bj][m][0], b = acc[ai][bj][m][1];
                    bf16_t* dst = (bf16_t*)((char*)O + blk_off(row, col0 + 32 * bj, ldo / 64));
#pragma unroll
                    for (int j = 0; j < 4; ++j) { const float ra = fmaxf(a[j], 0.f), rb = fmaxf(b[j], 0.f); a[j] = ra * ra; b[j] = rb * rb; }
                    store8_bf16_nt(dst, a, b); }
            }
    }
};
template <bool RB, bool OB> struct EpiResT {
    const void* res; void* out; const float* gate; const float* cscale;
    __device__ __forceinline__ void operator()(const f32x4 (&acc)[2][2][4][2], const Unit& u, int wr, int wc, int fr, int fq) const {
        const int row0 = u.pm * BM + wr * 64 + fr, col0 = u.pn * BM + wc * 64 + fq * 8;
        const int b = u.pm >> 5;
        f32x4 gv[2][2];
#pragma unroll
        for (int bj = 0; bj < 2; ++bj)
#pragma unroll
            for (int n = 0; n < 2; ++n) { f32x4 t = *(const f32x4*)(gate + (size_t)b * NMOD + col0 + 32 * bj + 4 * n);
                if (cscale) { const f32x4 s = *(const f32x4*)(cscale + col0 + 32 * bj + 4 * n); t = t * s; }
                gv[bj][n] = t; }
#pragma unroll
        for (int ai = 0; ai < 2; ++ai)
#pragma unroll
            for (int m = 0; m < 4; ++m) {
                const size_t off = (size_t)(row0 + ai * HALF + m * 16) * DM + col0;
#pragma unroll
                for (int bj = 0; bj < 2; ++bj) { f32x4 r0, r1; ld8<RB>(res, off + 32 * bj, r0, r1);
                    st8<OB>(out, off + 32 * bj, r0 + gv[bj][0] * acc[ai][bj][m][0], r1 + gv[bj][1] * acc[ai][bj][m][1]); }
            }
    }
};

__device__ void mod_task(const Params& P, int t, LAS float* sl) {
    const int tid = threadIdx.x, l = t / 96, n0 = (t % 96) * 64;
#pragma unroll
    for (int i = tid; i < 5 * 1024; i += 512) { const float v = (i < 4096) ? P.c[i] : P.c_ctx[i - 4096]; sl[i] = v / (1.0f + expf(-v)); }
    __syncthreads();
    const int kg = tid >> 6, ln = tid & 63;
    const float* w = P.w_mod + (size_t)l * DM * NMOD + n0 + ln;
    float a0 = 0.f, a1 = 0.f, a2 = 0.f, a3 = 0.f, a4 = 0.f;
#pragma unroll 8
    for (int k = kg * 128; k < kg * 128 + 128; ++k) { const float wv = w[(size_t)k * NMOD]; a0 += sl[k] * wv; a1 += sl[1024 + k] * wv; a2 += sl[2048 + k] * wv; a3 += sl[3072 + k] * wv; a4 += sl[4096 + k] * wv; }
    LAS float* red = sl + 5 * 1024;
    red[(kg * 5 + 0) * 64 + ln] = a0; red[(kg * 5 + 1) * 64 + ln] = a1; red[(kg * 5 + 2) * 64 + ln] = a2; red[(kg * 5 + 3) * 64 + ln] = a3; red[(kg * 5 + 4) * 64 + ln] = a4;
    __syncthreads();
    if (tid < 320) { const int r = tid >> 6, n = tid & 63; float s = 0.f;
        for (int g = 0; g < 8; ++g) s += red[(g * 5 + r) * 64 + n];
        s += P.b_mod[l * NMOD + n0 + n];
        float* modl = (float*)(P.ws + (l ? WS_MOD1 : WS_MOD0));
        if (r < 4) modl[r * NMOD + n0 + n] = s; else if (l == 0 && n0 + n < 2048) ((float*)(P.ws + WS_MODC))[n0 + n] = s; }
    __syncthreads();
}
__device__ void fold_win_task(const Params& P, int t, LAS float* sl) {
    const int tid = threadIdx.x, g = t >> 4, k0 = (t & 15) * 64;
    LAS float* wt = sl;
    LAS float* ctab = sl + 64 * 132;
    { const int r = tid >> 5, c4 = tid & 31;
#pragma unroll
        for (int i = 0; i < 4; ++i) { const f32x4 v = *(const f32x4*)(P.w_in + (size_t)(k0 + r + 16 * i) * PW + g * 128 + c4 * 4); LAS float* d = wt + (r + 16 * i) * 132 + c4 * 4; d[0] = v[0]; d[1] = v[1]; d[2] = v[2]; d[3] = v[3]; } }
    if (tid < 128) ctab[tid] = cospif((float)tid * (1.0f / 64.0f));
    __syncthreads();
    const int jj = tid & 127, kq = tid >> 7;
    float acc[16];
#pragma unroll
    for (int i = 0; i < 16; ++i) acc[i] = 0.f;
    const int mul = (jj <= 64) ? jj : (jj - 64), sub = (jj <= 64) ? 0 : 32;
    for (int c = 0; c < 128; c += 4) {
        const float d0 = ctab[(mul * c - sub) & 127], d1 = ctab[(mul * (c + 1) - sub) & 127], d2 = ctab[(mul * (c + 2) - sub) & 127], d3 = ctab[(mul * (c + 3) - sub) & 127];
#pragma unroll
        for (int i = 0; i < 16; ++i) { const f32x4 w = *(const LAS f32x4*)(wt + (kq * 16 + i) * 132 + c); acc[i] += w[0] * d0 + w[1] * d1 + w[2] * d2 + w[3] * d3; }
    }
    bf16_t* dst = (bf16_t*)(P.ws + WS_WIN) + (size_t)phys_row(g * 128 + jj, 0) * DM + k0 + kq * 16;
    store16_bf16(dst, acc);
    __syncthreads();
}
__device__ void fold_wout_task(const Params& P, int t, LAS float* sl) {
    const int tid = threadIdx.x, g = t >> 4, d0 = (t & 15) * 64;
    LAS float* wfp = sl;
    LAS float* wo = sl + 128 * 128;
    const float* base = P.w_four + (size_t)g * 128 * 128;
#pragma unroll 8
    for (int idx = tid; idx < 128 * 128; idx += 512) { const int jj = idx >> 7, e = idx & 127; float v;
        if (jj == 0 || jj == 64) v = base[jj * 128 + e];
        else if (jj < 64) v = base[jj * 128 + e] + base[(128 - jj) * 128 + e];
        else { const int l = jj - 64; v = base[(128 - l) * 128 + e] - base[l * 128 + e]; }
        wfp[idx] = v; }
    { const int r = tid >> 4, c4 = tid & 15;
#pragma unroll
        for (int i = 0; i < 4; ++i) { const f32x4 v = *(const f32x4*)(P.w_out + (size_t)(g * 128 + r + 32 * i) * DM + d0 + c4 * 4); LAS float* d = wo + (r + 32 * i) * 64 + c4 * 4; d[0] = v[0]; d[1] = v[1]; d[2] = v[2]; d[3] = v[3]; } }
    __syncthreads();
    const int dd = tid & 63, jq = tid >> 6;
    float acc[16];
#pragma unroll
    for (int i = 0; i < 16; ++i) acc[i] = 0.f;
    for (int e = 0; e < 128; e += 4) {
        const float w0 = wo[e * 64 + dd], w1 = wo[(e + 1) * 64 + dd], w2 = wo[(e + 2) * 64 + dd], w3 = wo[(e + 3) * 64 + dd];
#pragma unroll
        for (int i = 0; i < 16; ++i) { const f32x4 f = *(const LAS f32x4*)(wfp + (jq * 16 + i) * 128 + e); acc[i] += f[0] * w0 + f[1] * w1 + f[2] * w2 + f[3] * w3; }
    }
    bf16_t* dst = (bf16_t*)(P.ws + WS_WOUT) + (size_t)phys_row(d0 + dd, 0) * DM + g * 128 + jq * 16;
    store16_bf16(dst, acc);
    __syncthreads();
}
__device__ void conv_tile(const float* src, int ld, int k0, int n0, bf16_t* dst, int ldd, int kdst0, int ndst0, int mode, LAS float* sl, int blocked = 0) {
    const int tid = threadIdx.x;
    { const int r = tid >> 4, c4 = tid & 15;
        f32x4 v[4][2];
#pragma unroll
        for (int t = 0; t < 4; ++t)
#pragma unroll
            for (int i = 0; i < 2; ++i) v[t][i] = *(const f32x4*)(src + (size_t)(k0 + r + 32 * i) * ld + n0 + t * 64 + c4 * 4);
#pragma unroll
        for (int t = 0; t < 4; ++t)
#pragma unroll
            for (int i = 0; i < 2; ++i) { LAS float* d = sl + t * (64 * 65) + (r + 32 * i) * 65 + c4 * 4; d[0] = v[t][i][0]; d[1] = v[t][i][1]; d[2] = v[t][i][2]; d[3] = v[t][i][3]; } }
    __syncthreads();
    { const int nn = tid >> 3, kc = tid & 7;
#pragma unroll
        for (int t = 0; t < 4; ++t) { float v[8];
#pragma unroll
            for (int i = 0; i < 8; ++i) v[i] = sl[t * (64 * 65) + (kc * 8 + i) * 65 + nn];
            u32x4 w; w.x = cvt_pk_bf16(v[0], v[1]); w.y = cvt_pk_bf16(v[2], v[3]); w.z = cvt_pk_bf16(v[4], v[5]); w.w = cvt_pk_bf16(v[6], v[7]);
            const int prow = phys_row(ndst0 + n0 + t * 64 + nn, mode), pcol = kdst0 + k0 + kc * 8;
            if (blocked) *(u32x4*)((char*)dst + blk_off(prow, pcol, ldd / 64)) = w; else *(u32x4*)(dst + (size_t)prow * ldd + pcol) = w; } }
    __syncthreads();
}
__device__ void dft_tab_task(const Params& P) {
    bf16_t* d1c = (bf16_t*)(P.ws + WS_D1C); bf16_t* d1s = (bf16_t*)(P.ws + WS_D1S); bf16_t* d2 = (bf16_t*)(P.ws + WS_D2);
    for (int idx = threadIdx.x; idx < 128 * 128; idx += 512) { const int ka = idx >> 7, a = idx & 127; const float ang = (float)((ka * a) & 127) * (1.0f / 64.0f);
        d1c[idx] = (bf16_t)(cvt_pk_bf16(cospif(ang), 0.f) & 0xffff); d1s[idx] = (bf16_t)(cvt_pk_bf16(-sinpif(ang), 0.f) & 0xffff); }
    for (int idx = threadIdx.x; idx < 64 * 128; idx += 512) { const int kb = idx >> 7, kk = idx & 127, bb = kk >> 1; const float ang = (float)((kb * bb) & 63) * (1.0f / 32.0f);
        const float v = ((kk & 1) ? sinpif(ang) : cospif(ang)) * (1.0f / 32.0f);
        d2[idx] = (bf16_t)(cvt_pk_bf16(v, 0.f) & 0xffff); }
}
__device__ void phase0(const Params& P, LAS unsigned char* lds) {
    LAS float* sl = (LAS float*)lds;
    constexpr int T_MOD = 192, T_FWIN = 64, T_FWOUT = 64, T_W1 = 512, T_W2 = 512, T_WIN = 96, T_WOUT = 32, T_POOL = 16, T_DFT = 1;
    constexpr int NTASK = T_MOD + T_FWIN + T_FWOUT + T_W1 + T_W2 + T_WIN + T_WOUT + T_POOL + T_DFT;
    unsigned* qhead = (unsigned*)(P.ws + WS_CTL) + 3600;
    volatile LAS unsigned* qslot = (volatile LAS unsigned*)(lds + LDS_BYTES - 8);
    for (;;) {
        __syncthreads();
        if (threadIdx.x == 0) *qslot = __hip_atomic_fetch_add(qhead, 1u, __ATOMIC_RELAXED, __HIP_MEMORY_SCOPE_AGENT);
        __syncthreads();
        const int t = (int)*qslot;
        if (t >= NTASK) break;
        int q = t;
        if (q < T_MOD) { mod_task(P, q, sl); continue; } q -= T_MOD;
        if (q < T_FWIN) { fold_win_task(P, q, sl); continue; } q -= T_FWIN;
        if (q < T_FWOUT) { fold_wout_task(P, q, sl); continue; } q -= T_FWOUT;
        if (q < T_W1) { const int l = q >> 8, r = q & 255, kt = r >> 4, ntile = r & 15;
            conv_tile(P.w_mlp1 + (size_t)l * DM * HID, HID, kt * 64, ntile * 256, (bf16_t*)(P.ws + WS_W1) + (size_t)l * HID * DM, DM, 0, 0, 0, sl); continue; } q -= T_W1;
        if (q < T_W2) { const int l = q >> 8, r = q & 255, kt = r >> 2, ntile = r & 3;
            conv_tile(P.w_mlp2 + (size_t)l * HID * DM, DM, kt * 64, ntile * 256, (bf16_t*)(P.ws + WS_W2) + (size_t)l * DM * HID, HID, 0, 0, 0, sl, 1); continue; } q -= T_W2;
        if (q < T_WIN) { const int kt = q / 6, ntile = q % 6;
            conv_tile(P.w_in, PW, kt * 64, 512 + ntile * 256, (bf16_t*)(P.ws + WS_WIN), DM, 0, 0, 0, sl); continue; } q -= T_WIN;
        if (q < T_WOUT) { const int kt = q >> 2, ntile = q & 3;
            conv_tile(P.w_out + (size_t)512 * DM, DM, kt * 64, ntile * 256, (bf16_t*)(P.ws + WS_WOUT), DM, 512, 0, 0, sl); continue; } q -= T_WOUT;
        if (q < T_POOL) { const int g = q >> 2, kt = q & 3;
            conv_tile(P.w_pool + (size_t)g * 256 * 256, 256, kt * 64, 0, (bf16_t*)(P.ws + WS_WPOOL), 256, 0, g * 256, 0, sl); continue; } q -= T_POOL;
        dft_tab_task(P);
    }
}

template <int NR, bool SB>
__device__ __forceinline__ void norm_rows(const void* src, size_t srow, bf16_t* dst, const f32x4 (&gs)[4], const f32x4 (&sh)[4], int lane, bf16_t* cpy = nullptr) {
    f32x4 v[NR][4]; float ss[NR];
#pragma unroll
    for (int r = 0; r < NR; ++r)
#pragma unroll
        for (int j = 0; j < 2; ++j) ld8<SB>(src, (srow + r) * DM + j * 512 + lane * 8, v[r][2 * j], v[r][2 * j + 1]);
#pragma unroll
    for (int r = 0; r < NR; ++r) { ss[r] = 0.f;
#pragma unroll
        for (int i = 0; i < 4; ++i) ss[r] += v[r][i][0] * v[r][i][0] + v[r][i][1] * v[r][i][1] + v[r][i][2] * v[r][i][2] + v[r][i][3] * v[r][i][3]; }
#pragma unroll
    for (int o = 32; o >= 1; o >>= 1)
#pragma unroll
        for (int r = 0; r < NR; ++r) ss[r] += __shfl_xor(ss[r], o);
#pragma unroll
    for (int r = 0; r < NR; ++r) { const float rs = rsqrtf(ss[r] * (1.0f / 1024.0f) + 1e-6f);
#pragma unroll
        for (int j = 0; j < 2; ++j) { const f32x4 a = v[r][2 * j] * rs * gs[2 * j] + sh[2 * j], b = v[r][2 * j + 1] * rs * gs[2 * j + 1] + sh[2 * j + 1];
            st8<true>(dst, (size_t)r * DM + j * 512 + lane * 8, a, b);
            if (cpy) st8<true>(cpy, (size_t)r * DM + j * 512 + lane * 8, v[r][2 * j], v[r][2 * j + 1]); } }
}
__device__ __forceinline__ void load_mod_vecs(const float* gn, const float* shift, const float* scale, f32x4 (&gs)[4], f32x4 (&sh)[4], int lane) {
#pragma unroll
    for (int i = 0; i < 4; ++i) { const int c = (i >> 1) * 512 + lane * 8 + (i & 1) * 4; const f32x4 g = *(const f32x4*)(gn + c), s = *(const f32x4*)(scale + c); gs[i] = g * (s + 1.0f); sh[i] = *(const f32x4*)(shift + c); }
}
template <bool SB>
__device__ __forceinline__ void norm_pass(const void* src, bf16_t* dst, const float* gn, const float* mod, int which, const Params* Pctx, bf16_t* cpy = nullptr) {
    int ltid_ = threadIdx.x; asm volatile("" : "+v"(ltid_));
    const int lane = ltid_ & 63, gw = blockIdx.x * 8 + (ltid_ >> 6), nw = gridDim.x * 8;
    f32x4 gs[4], sh[4];
    int curb = -1;
    for (int r = gw * 4; r < NT; r += nw * 4) {
        const int b = r >> 13;
        if (b != curb) { curb = b; load_mod_vecs(gn, mod + (size_t)b * NMOD + which * 3072, mod + (size_t)b * NMOD + which * 3072 + 1024, gs, sh, lane); }
        norm_rows<4, SB>(src, (size_t)r, dst + (size_t)r * DM, gs, sh, lane, cpy ? cpy + (size_t)r * DM : nullptr);
    }
    if (Pctx) {
        const float* modc = (const float*)(Pctx->ws + WS_MODC);
        load_mod_vecs(gn, modc, modc + 1024, gs, sh, lane);
        for (int r = gw; r < NCTX; r += nw) norm_rows<1, false>(Pctx->ctx, (size_t)r, dst + (size_t)(NT + r) * DM, gs, sh, lane);
    }
}

constexpr int ACT_PITCH = 260;
__device__ __forceinline__ void dft_load_tile(const bf16_t* src, size_t row_stride, LAS unsigned char* act) {
    const int tid = threadIdx.x, chunk = tid & 31, r0 = tid >> 5;
#pragma unroll
    for (int i = 0; i < 8; ++i) { const int r = r0 + 16 * i; const u32x4 v = *(const u32x4*)(src + (size_t)r * row_stride + chunk * 8);
        LAS u32x2* d = (LAS u32x2*)(act + r * (ACT_PITCH * 2) + chunk * 16); d[0] = (u32x2){v.x, v.y}; d[1] = (u32x2){v.z, v.w}; }
}
__device__ __forceinline__ bf16x8 dft_gather(const LAS unsigned char* act, int kc, int fq, int ch) {
    const LAS bf16_t* p = (const LAS bf16_t*)act + (kc * 32 + fq * 8) * ACT_PITCH + ch;
    bf16x8 r;
#pragma unroll
    for (int i = 0; i < 8; ++i) r[i] = (short)p[i * ACT_PITCH];
    return r;
}
__device__ void dft_stage1(const Params& P, LAS unsigned char* lds) {
    const int tid = threadIdx.x, wid = tid >> 6, lane = tid & 63, fr = lane & 15, fq = lane >> 4;
    LAS unsigned char* d1c = lds; LAS unsigned char* d1s = lds + 34816; LAS unsigned char* act = lds + 69632;
    __syncthreads();
#pragma unroll
    for (int id = tid; id < 2 * 2048; id += 512) { const int mtx = id >> 11, r = (id >> 4) & 127, ch = id & 15;
        const u32x4 v = *(const u32x4*)(P.ws + (mtx ? WS_D1S : WS_D1C) + r * 256 + ch * 16);
        *(LAS u32x4*)((mtx ? d1s : d1c) + r * 272 + ch * 16) = v; }
    const bf16_t* pbuf = (const bf16_t*)(P.ws + WS_BIG + BIG_P);
    bf16_t* s1 = (bf16_t*)(P.ws + WS_BIG + BIG_S1);
    for (int u = blockIdx.x; u < NB * 64 * 2; u += gridDim.x) {
        const int half = u & 1, bb = (u >> 1) & 63, b = u >> 7;
        __syncthreads();
        dft_load_tile(pbuf + ((size_t)b * SEQ + bb) * PW + half * 256, (size_t)64 * PW, act);
        __syncthreads();
#pragma unroll 1
        for (int cti = 0; cti < 2; ++cti) {
            const int ct = wid * 2 + cti;
            bf16x8 af[4];
#pragma unroll
            for (int kc = 0; kc < 4; ++kc) af[kc] = dft_gather(act, kc, fq, ct * 16 + fr);
            const int chg = half * 256 + ct * 16 + fq * 4;
#pragma unroll 1
            for (int kt = 0; kt < 8; ++kt) {
                f32x4 aR = (f32x4){0.f, 0.f, 0.f, 0.f}, aI = (f32x4){0.f, 0.f, 0.f, 0.f};
#pragma unroll
                for (int kc = 0; kc < 4; ++kc) {
                    const bf16x8 bc = *(const LAS bf16x8*)(d1c + (kt * 16 + fr) * 272 + (kc * 32 + fq * 8) * 2);
                    const bf16x8 bs = *(const LAS bf16x8*)(d1s + (kt * 16 + fr) * 272 + (kc * 32 + fq * 8) * 2);
                    aR = __builtin_amdgcn_mfma_f32_16x16x32_bf16(af[kc], bc, aR, 0, 0, 0);
                    aI = __builtin_amdgcn_mfma_f32_16x16x32_bf16(af[kc], bs, aI, 0, 0, 0);
                }
                const int ka = kt * 16 + fr;
                float sph, cph; sincospif((float)((ka * bb) & 8191) * (1.0f / 4096.0f), &sph, &cph);
                cph *= (1.0f / 32.0f); sph *= (1.0f / 32.0f);
                float re[4], im[4];
#pragma unroll
                for (int j = 0; j < 4; ++j) { const float x = aR[j], y = aI[j]; const float r0 = x * cph + y * sph, i0 = y * cph - x * sph;
                    const bool isq = ((chg + j) & 127) > 64; re[j] = isq ? -i0 : r0; im[j] = isq ? r0 : i0; }
                bf16_t* d = s1 + ((((size_t)b * 128 + ka) * 64 + bb) * 2) * 512 + chg;
                *(u32x2*)d = (u32x2){cvt_pk_bf16(re[0], re[1]), cvt_pk_bf16(re[2], re[3])};
                *(u32x2*)(d + 512) = (u32x2){cvt_pk_bf16(im[0], im[1]), cvt_pk_bf16(im[2], im[3])};
            }
        }
    }
    __syncthreads();
}
__device__ void dft_stage2(const Params& P, LAS unsigned char* lds) {
    const int tid = threadIdx.x, wid = tid >> 6, lane = tid & 63, fr = lane & 15, fq = lane >> 4;
    LAS unsigned char* d2 = lds; LAS unsigned char* act = lds + 17408;
    __syncthreads();
#pragma unroll
    for (int id = tid; id < 1024; id += 512) { const int r = id >> 4, ch = id & 15; *(LAS u32x4*)(d2 + r * 272 + ch * 16) = *(const u32x4*)(P.ws + WS_D2 + r * 256 + ch * 16); }
    const bf16_t* s1 = (const bf16_t*)(P.ws + WS_BIG + BIG_S1);
    bf16_t* cat = (bf16_t*)(P.ws + WS_BIG + BIG_CAT);
    for (int u = blockIdx.x; u < NB * 128 * 2; u += gridDim.x) {
        const int half = u & 1, ka = (u >> 1) & 127, b = u >> 8;
        __syncthreads();
        dft_load_tile(s1 + (((size_t)b * 128 + ka) * 128) * 512 + half * 256, 512, act);
        __syncthreads();
#pragma unroll 1
        for (int cti = 0; cti < 2; ++cti) {
            const int ct = wid * 2 + cti;
            bf16x8 af[4];
#pragma unroll
            for (int kc = 0; kc < 4; ++kc) af[kc] = dft_gather(act, kc, fq, ct * 16 + fr);
            f32x4 acc[4];
#pragma unroll
            for (int kt = 0; kt < 4; ++kt) acc[kt] = (f32x4){0.f, 0.f, 0.f, 0.f};
#pragma unroll
            for (int kt = 0; kt < 4; ++kt)
#pragma unroll
                for (int kc = 0; kc < 4; ++kc) {
                    const bf16x8 bv = *(const LAS bf16x8*)(d2 + (kt * 16 + fr) * 272 + (kc * 32 + fq * 8) * 2);
                    acc[kt] = __builtin_amdgcn_mfma_f32_16x16x32_bf16(af[kc], bv, acc[kt], 0, 0, 0);
                }
#pragma unroll
            for (int kt = 0; kt < 4; ++kt) { const int kb = kt * 16 + fr; const size_t tok = (size_t)b * SEQ + ka + 128 * kb;
                *(u32x2*)(cat + tok * 1024 + half * 256 + ct * 16 + fq * 4) = (u32x2){cvt_pk_bf16(acc[kt][0], acc[kt][1]), cvt_pk_bf16(acc[kt][2], acc[kt][3])}; }
        }
    }
    __syncthreads();
}

constexpr int VP = 160;
__device__ void natten_phase(const Params& P, LAS unsigned char* lds) {
    const int tid = threadIdx.x, wid = __builtin_amdgcn_readfirstlane(tid >> 6), lane = tid & 63, fr = lane & 15, fq = lane >> 4;
    LAS unsigned char* vimg = lds;
    LAS float* rpbs = (LAS float*)(lds + 832 * VP);
    const bf16_t* pbuf = (const bf16_t*)(P.ws + WS_BIG + BIG_P);
    bf16_t* cat = (bf16_t*)(P.ws + WS_BIG + BIG_CAT);
    const int upb = (NB * 8 * 64 + gridDim.x - 1) / gridDim.x;
    int lastbh = -1;
    for (int u = blockIdx.x * upb; u < min((int)(blockIdx.x + 1) * upb, NB * 8 * 64); ++u) {
        const int rp = u & 63, h = (u >> 6) & 7, b = u >> 9;
        const bool newbh = ((u >> 6) != lastbh); lastbh = u >> 6;
        const int rs0 = min(max(2 * rp - 4, 0), 120), rs1 = min(max(2 * rp - 3, 0), 120), nrows = rs1 - rs0 + 8;
        __syncthreads();
        {
            u32x4 tv[13];
            const int ch = tid & 7, r0 = tid >> 3;
            const bf16_t* vw = pbuf + ((size_t)b * SEQ + rs0 * 64 + r0) * PW + 1536 + h * 64 + ch * 8;
            const bf16_t* vc = pbuf + ((size_t)NT + b * CTXL + r0) * PW + 1536 + h * 64 + ch * 8;
#pragma unroll
            for (int i = 0; i < 8; ++i) tv[i] = *(const u32x4*)(vw + (size_t)i * 64 * PW);
            if (nrows == 9) tv[8] = *(const u32x4*)(vw + (size_t)8 * 64 * PW);
            if (newbh) {
#pragma unroll
                for (int i = 0; i < 4; ++i) tv[9 + i] = *(const u32x4*)(vc + (size_t)i * 64 * PW); }
#pragma unroll
            for (int i = 0; i < 8; ++i) *(LAS u32x4*)(vimg + (r0 + 64 * i) * VP + ch * 16) = tv[i];
            if (nrows == 9) *(LAS u32x4*)(vimg + (r0 + 512) * VP + ch * 16) = tv[8];
            if (newbh) {
#pragma unroll
                for (int i = 0; i < 4; ++i) *(LAS u32x4*)(vimg + (576 + r0 + 64 * i) * VP + ch * 16) = tv[9 + i]; }
        }
        if (newbh && tid < 465) rpbs[tid] = P.rpb[h * 465 + tid] * 1.44269504f;
        __syncthreads();
        const int r = 2 * rp + (wid >> 2), qt = wid & 3, c0 = (qt == 0) ? 0 : (qt == 1 ? 8 : (qt == 2 ? 24 : 32));
        const int rs = min(max(r - 4, 0), 120);
        const size_t qtok = (size_t)b * SEQ + r * 64 + qt * 16 + fr;
        const unsigned lofs = (unsigned)(fr * PW + fq * 8) * 2u;
        const char* qbase = (const char*)(pbuf + ((size_t)b * SEQ + r * 64 + qt * 16) * PW + 512 + h * 64);
        const char* kbase = (const char*)(pbuf + ((size_t)b * SEQ + rs * 64 + c0) * PW + 1024 + h * 64);
        const char* cbase = (const char*)(pbuf + ((size_t)NT + b * CTXL) * PW + 1024 + h * 64);
        const bf16x8 q0 = *(const bf16x8*)(qbase + lofs);
        const bf16x8 q1 = *(const bf16x8*)(qbase + 64 + lofs);
        f32x4 s[32];
#pragma unroll
        for (int t = 0; t < 16; ++t) {
            const unsigned toff = (unsigned)(((t >> 1) * 64 + (t & 1) * 16) * PW * 2);
            const bf16x8 k0 = *(const bf16x8*)(kbase + toff + lofs);
            const bf16x8 k1 = *(const bf16x8*)(kbase + toff + 64 + lofs);
            f32x4 a = (f32x4){0.f, 0.f, 0.f, 0.f};
            a = __builtin_amdgcn_mfma_f32_16x16x32_bf16(k0, q0, a, 0, 0, 0);
            s[t] = __builtin_amdgcn_mfma_f32_16x16x32_bf16(k1, q1, a, 0, 0, 0);
        }
#pragma unroll
        for (int t = 0; t < 16; ++t) {
            const unsigned toff = (unsigned)(t * 16 * PW * 2);
            const bf16x8 k0 = *(const bf16x8*)(cbase + toff + lofs);
            const bf16x8 k1 = *(const bf16x8*)(cbase + toff + 64 + lofs);
            f32x4 a = (f32x4){0.f, 0.f, 0.f, 0.f};
            a = __builtin_amdgcn_mfma_f32_16x16x32_bf16(k0, q0, a, 0, 0, 0);
            s[16 + t] = __builtin_amdgcn_mfma_f32_16x16x32_bf16(k1, q1, a, 0, 0, 0);
        }
        const int cq = qt * 16 + fr, cst = min(max(cq - 8, 0), 48);
        const int vlo = cst - c0 - fq * 4;
        const LAS float* brow = rpbs + (rs - r + 7) * 31 + (15 + c0 + fq * 4 - cq);
        float mx = -1e30f;
#pragma unroll
        for (int t = 0; t < 16; ++t) {
#pragma unroll
            for (int j = 0; j < 4; ++j) { const int off = (t & 1) * 16 + j;
                const float v = ((unsigned)(off - vlo) < 16u) ? s[t][j] + brow[(t >> 1) * 31 + off] : -1e30f; s[t][j] = v; mx = fmaxf(mx, v); }
        }
#pragma unroll
        for (int t = 16; t < 32; ++t)
#pragma unroll
            for (int j = 0; j < 4; ++j) mx = fmaxf(mx, s[t][j]);
        mx = fmaxf(mx, __shfl_xor(mx, 16)); mx = fmaxf(mx, __shfl_xor(mx, 32));
        float sum = 0.f;
#pragma unroll
        for (int t = 0; t < 32; ++t)
#pragma unroll
            for (int j = 0; j < 4; ++j) { const float p = __builtin_amdgcn_exp2f(s[t][j] - mx); s[t][j] = p; sum += p; }
        sum += __shfl_xor(sum, 16); sum += __shfl_xor(sum, 32);
        f32x4 o[4];
#pragma unroll
        for (int dt = 0; dt < 4; ++dt) o[dt] = (f32x4){0.f, 0.f, 0.f, 0.f};
        const int trq = (lane >> 2) & 3, trp = lane & 3;
#pragma unroll
        for (int pi = 0; pi < 16; ++pi) {
            const int t0 = 2 * pi, t1 = 2 * pi + 1;
            int rb0, rb1;
            if (pi < 8) { rb0 = (rs + pi - rs0) * 64 + c0; rb1 = rb0 + 16; } else { rb0 = 576 + (t0 - 16) * 16; rb1 = rb0 + 16; }
            bf16x8 pf; { const unsigned a0 = cvt_pk_bf16(s[t0][0], s[t0][1]), a1 = cvt_pk_bf16(s[t0][2], s[t0][3]), a2 = cvt_pk_bf16(s[t1][0], s[t1][1]), a3 = cvt_pk_bf16(s[t1][2], s[t1][3]);
                u32x4 w = (u32x4){a0, a1, a2, a3}; pf = __builtin_bit_cast(bf16x8, w); }
#pragma unroll
            for (int dt = 0; dt < 4; ++dt) {
                const s16x4 v0 = __builtin_amdgcn_ds_read_tr16_b64_v4i16((LAS s16x4*)(vimg + (rb0 + fq * 4 + trq) * VP + (dt * 16 + trp * 4) * 2));
                const s16x4 v1 = __builtin_amdgcn_ds_read_tr16_b64_v4i16((LAS s16x4*)(vimg + (rb1 + fq * 4 + trq) * VP + (dt * 16 + trp * 4) * 2));
                bf16x8 vf; vf[0] = v0[0]; vf[1] = v0[1]; vf[2] = v0[2]; vf[3] = v0[3]; vf[4] = v1[0]; vf[5] = v1[1]; vf[6] = v1[2]; vf[7] = v1[3];
                o[dt] = __builtin_amdgcn_mfma_f32_16x16x32_bf16(vf, pf, o[dt], 0, 0, 0);
            }
        }
        const float inv = 1.0f / sum;
#pragma unroll
        for (int dt = 0; dt < 4; ++dt)
            *(u32x2*)(cat + qtok * 1024 + 512 + h * 64 + dt * 16 + fq * 4) = (u32x2){cvt_pk_bf16(o[dt][0] * inv, o[dt][1] * inv), cvt_pk_bf16(o[dt][2] * inv, o[dt][3] * inv)};
    }
    __syncthreads();
}

template <int HW>
__device__ __forceinline__ void pool_item(const bf16_t* u, bf16_t* pooled, int t, int chunk) {
    const int tl = t & (SEQ - 1);
    const bf16_t* base = u + (size_t)(t - tl) * DM + chunk * 8;
    float a[8];
#pragma unroll
    for (int i = 0; i < 8; ++i) a[i] = 0.f;
    u32x4 v[2 * HW];
#pragma unroll
    for (int d = 0; d < 2 * HW; ++d) { const int r = tl - HW + d, rc = min(max(r, 0), SEQ - 1); v[d] = *(const u32x4*)(base + (size_t)rc * DM); }
#pragma unroll
    for (int d = 0; d < 2 * HW; ++d) { const int r = tl - HW + d; const float w = (r >= 0 && r < SEQ) ? 1.0f : 0.0f;
        a[0] += w * bf_lo(v[d].x); a[1] += w * bf_hi(v[d].x); a[2] += w * bf_lo(v[d].y); a[3] += w * bf_hi(v[d].y); a[4] += w * bf_lo(v[d].z); a[5] += w * bf_hi(v[d].z); a[6] += w * bf_lo(v[d].w); a[7] += w * bf_hi(v[d].w); }
    const int lo = max(tl - HW, 0), hi = min(tl + HW, SEQ);
    const float ic = 1.0f / (float)(hi - lo);
    const u32x4 c = v[HW];
    u32x4 w; w.x = cvt_pk_bf16(a[0] * ic - bf_lo(c.x), a[1] * ic - bf_hi(c.x)); w.y = cvt_pk_bf16(a[2] * ic - bf_lo(c.y), a[3] * ic - bf_hi(c.y));
    w.z = cvt_pk_bf16(a[4] * ic - bf_lo(c.z), a[5] * ic - bf_hi(c.z)); w.w = cvt_pk_bf16(a[6] * ic - bf_lo(c.w), a[7] * ic - bf_hi(c.w));
    *(u32x4*)(pooled + (size_t)t * DM + chunk * 8) = w;
}
__device__ void pool_pass(const bf16_t* u, bf16_t* pooled) {
    const int lane = threadIdx.x & 63, gw = blockIdx.x * 8 + (threadIdx.x >> 6), nw = gridDim.x * 8;
    for (int wi = gw; wi < (NT / 2) * 4; wi += nw) {
        const int gi = wi & 3, t = (wi >> 2) * 2 + (lane >> 5), chunk = gi * 32 + (lane & 31);
        if (gi == 0) pool_item<1>(u, pooled, t, chunk); else if (gi == 1) pool_item<2>(u, pooled, t, chunk); else if (gi == 2) pool_item<4>(u, pooled, t, chunk); else pool_item<8>(u, pooled, t, chunk);
    }
}

template <int HW>
__device__ __forceinline__ void pool_from_lds(const LAS unsigned char* U, bf16_t* pooled, int t0, int tl0, int tbase, int chunk) {
#pragma unroll 2
    for (int i = 0; i < 8; ++i) {
        const int t = tbase + i, tl = tl0 + t;
        float a[8];
#pragma unroll
        for (int k = 0; k < 8; ++k) a[k] = 0.f;
#pragma unroll
        for (int d = 0; d < 2 * HW; ++d) { const int r = tl - HW + d; const float w = (r >= 0 && r < SEQ) ? 1.0f : 0.0f;
            const u32x4 v = *(const LAS u32x4*)(U + (t + 8 - HW + d) * 2048 + chunk * 16);
            a[0] += w * bf_lo(v.x); a[1] += w * bf_hi(v.x); a[2] += w * bf_lo(v.y); a[3] += w * bf_hi(v.y); a[4] += w * bf_lo(v.z); a[5] += w * bf_hi(v.z); a[6] += w * bf_lo(v.w); a[7] += w * bf_hi(v.w); }
        const int lo = max(tl - HW, 0), hi = min(tl + HW, SEQ);
        const float ic = 1.0f / (float)(hi - lo);
        const u32x4 c = *(const LAS u32x4*)(U + (t + 8) * 2048 + chunk * 16);
        u32x4 w; w.x = cvt_pk_bf16(a[0] * ic - bf_lo(c.x), a[1] * ic - bf_hi(c.x)); w.y = cvt_pk_bf16(a[2] * ic - bf_lo(c.y), a[3] * ic - bf_hi(c.y));
        w.z = cvt_pk_bf16(a[4] * ic - bf_lo(c.z), a[5] * ic - bf_hi(c.z)); w.w = cvt_pk_bf16(a[6] * ic - bf_lo(c.w), a[7] * ic - bf_hi(c.w));
        *(u32x4*)(pooled + (size_t)(t0 + t) * DM + chunk * 8) = w;
    }
}
__device__ void pool_norm_fused(const bf16_t* h, const float* gn, const float* mod, bf16_t* pooled, LAS unsigned char* lds) {
    int tid = threadIdx.x; asm volatile("" : "+v"(tid));
    const int wid = tid >> 6, lane = tid & 63;
    for (int ck = blockIdx.x; ck < NT / 32; ck += gridDim.x) {
        const int t0 = ck * 32, b = t0 >> 13, tl0 = t0 & (SEQ - 1);
        f32x4 gs[4], sh[4];
        load_mod_vecs(gn, mod + (size_t)b * NMOD, mod + (size_t)b * NMOD + 1024, gs, sh, lane);
        __syncthreads();
#pragma unroll 1
        for (int rr = 0; rr < 6; rr += 2) {
            f32x4 v[2][4]; float ss[2];
#pragma unroll
            for (int q = 0; q < 2; ++q) { const int row = wid * 6 + rr + q, tl = min(max(tl0 - 8 + row, 0), SEQ - 1);
#pragma unroll
                for (int j = 0; j < 2; ++j) ld8<true>(h, ((size_t)b * SEQ + tl) * DM + j * 512 + lane * 8, v[q][2 * j], v[q][2 * j + 1]); }
#pragma unroll
            for (int q = 0; q < 2; ++q) { ss[q] = 0.f;
#pragma unroll
                for (int i = 0; i < 4; ++i) ss[q] += v[q][i][0] * v[q][i][0] + v[q][i][1] * v[q][i][1] + v[q][i][2] * v[q][i][2] + v[q][i][3] * v[q][i][3]; }
#pragma unroll
            for (int o = 32; o >= 1; o >>= 1) { ss[0] += __shfl_xor(ss[0], o); ss[1] += __shfl_xor(ss[1], o); }
#pragma unroll
            for (int q = 0; q < 2; ++q) { const float rs = rsqrtf(ss[q] * (1.0f / 1024.0f) + 1e-6f); const int row = wid * 6 + rr + q;
#pragma unroll
                for (int j = 0; j < 2; ++j) { const f32x4 a = v[q][2 * j] * rs * gs[2 * j] + sh[2 * j], c = v[q][2 * j + 1] * rs * gs[2 * j + 1] + sh[2 * j + 1];
                    u32x4 w; w.x = cvt_pk_bf16(a[0], a[1]); w.y = cvt_pk_bf16(a[2], a[3]); w.z = cvt_pk_bf16(c[0], c[1]); w.w = cvt_pk_bf16(c[2], c[3]);
                    *(LAS u32x4*)(lds + row * 2048 + (j * 512 + lane * 8) * 2) = w; } }
        }
        __syncthreads();
        const int g = wid & 3, chunk = g * 32 + (lane & 31), tbase = (wid >> 2) * 16 + (lane >> 5) * 8;
        if (g == 0) pool_from_lds<1>(lds, pooled, t0, tl0, tbase, chunk); else if (g == 1) pool_from_lds<2>(lds, pooled, t0, tl0, tbase, chunk);
        else if (g == 2) pool_from_lds<4>(lds, pooled, t0, tl0, tbase, chunk); else pool_from_lds<8>(lds, pooled, t0, tl0, tbase, chunk);
    }
    __syncthreads();
}

#define XB_TMO      128
#define XB_XCNT(j)  (256  + 64 * (j))
#define XB_XSUB(j)  (1280 + 64 * (j))
#define XB_XGEN(j)  (2304 + 64 * (j))
#define XB_TOP      3328
#define XB_TOPGEN   3392
#define XCD_BAR_WORDS 3456
#define XB_SPIN_CAP (1u << 18)
__device__ __forceinline__ unsigned xb_ld(unsigned* p)              { return __hip_atomic_load(p, __ATOMIC_RELAXED, __HIP_MEMORY_SCOPE_AGENT); }
__device__ __forceinline__ unsigned xb_add(unsigned* p, unsigned v) { return __hip_atomic_fetch_add(p, v, __ATOMIC_RELAXED, __HIP_MEMORY_SCOPE_AGENT); }
__device__ __forceinline__ unsigned xb_xcc_id() { return (unsigned)__builtin_amdgcn_s_getreg((3 << 11) | 20) & 0xFu; }
#define XB_SPIN(cond, bar) do { unsigned _sp = 0; while (cond) { __builtin_amdgcn_s_sleep(1); \
    if ((++_sp & 255u) == 0u) { if (xb_ld(&(bar)[XB_TMO])) break; if (_sp > XB_SPIN_CAP) { atomicAdd(&(bar)[XB_TMO], 1u); break; } } } } while (0)
struct XcdBarrier { unsigned* bar; unsigned x; volatile LAS unsigned* st; };
__device__ __forceinline__ XcdBarrier xcd_barrier_post(unsigned* bar, volatile LAS unsigned* st) {
    XcdBarrier b; b.bar = bar; b.x = xb_xcc_id(); b.st = st;
    if (threadIdx.x == 0) (void)xb_add(&bar[XB_XCNT(b.x)], 1u);
    return b;
}
__device__ __forceinline__ void xcd_barrier_complete(unsigned* bar, unsigned x, unsigned& nloc, unsigned& nx) {
    const unsigned G = gridDim.x * gridDim.y * gridDim.z;
    unsigned sum, cnt, mine, sp = 0u;
    for (;;) {
        sum = 0u; cnt = 0u; mine = 0u;
#pragma unroll
        for (unsigned j = 0; j < 16; ++j) { const unsigned c = xb_ld(&bar[XB_XCNT(j)]); sum += c; cnt += (c > 0u) ? 1u : 0u; mine = (j == x) ? c : mine; }
        if (sum == G) break;
        __builtin_amdgcn_s_sleep(1);
        if ((++sp & 255u) == 0u) { if (xb_ld(&bar[XB_TMO])) break; if (sp > XB_SPIN_CAP) { atomicAdd(&bar[XB_TMO], 1u); break; } }
    }
    nloc = mine > 0u ? mine : 1u; nx = cnt > 0u ? cnt : 1u;
}
__device__ __forceinline__ void xcd_barrier(const XcdBarrier& b) {
    asm volatile("s_waitcnt vmcnt(0)" ::: "memory");
    __syncthreads();
    if (threadIdx.x == 0) {
        unsigned* bar = b.bar;
        __builtin_amdgcn_s_waitcnt(0);
        unsigned nloc = b.st[0], nx = b.st[1];
        if (nloc == 0u) { xcd_barrier_complete(bar, b.x, nloc, nx); b.st[0] = nloc; b.st[1] = nx; }
        const unsigned old = xb_add(&bar[XB_XSUB(b.x)], 1u);
        const unsigned gen = old / nloc;
        if (old + 1u == (gen + 1u) * nloc) {
            __builtin_amdgcn_fence(__ATOMIC_RELEASE, "agent");
            asm volatile("s_waitcnt vmcnt(0)" ::: "memory");
            const unsigned og = xb_add(&bar[XB_TOP], 1u);
            const unsigned tg = og / nx;
            if (og + 1u == (tg + 1u) * nx) xb_add(&bar[XB_TOPGEN], 1u);
            else XB_SPIN(xb_ld(&bar[XB_TOPGEN]) == tg, bar);
            __builtin_amdgcn_fence(__ATOMIC_ACQUIRE, "agent");
            xb_add(&bar[XB_XGEN(b.x)], 1u);
            asm volatile("s_waitcnt vmcnt(0)" ::: "memory");
        } else {
            XB_SPIN(xb_ld(&bar[XB_XGEN(b.x)]) == gen, bar);
            __builtin_amdgcn_fence(__ATOMIC_ACQUIRE, "agent");
            asm volatile("s_waitcnt vmcnt(0)" ::: "memory");
        }
    }
    __syncthreads();
}

__global__ void __launch_bounds__(512, 2) fwd_megakernel(Params P) {
    extern __shared__ __attribute__((aligned(16))) unsigned char shm[];
    LAS unsigned char* lds = (LAS unsigned char*)shm;
    cg::grid_group grid = cg::this_grid();
    volatile LAS unsigned* xst = (volatile LAS unsigned*)(lds + LDS_BYTES - 16);
    if (threadIdx.x == 0) { xst[0] = 0u; xst[1] = 0u; }
    __syncthreads();
    const XcdBarrier xb = xcd_barrier_post((unsigned*)(P.ws + WS_CTL), xst);
#define GSYNC(n) xcd_barrier(xb)
    unsigned char* ws = P.ws;
    const float* mod0 = (const float*)(ws + WS_MOD0); const float* mod1 = (const float*)(ws + WS_MOD1);
    bf16_t* ubuf = (bf16_t*)(ws + WS_U);
    bf16_t* pbuf = (bf16_t*)(ws + WS_BIG + BIG_P);
    bf16_t* cat = (bf16_t*)(ws + WS_BIG + BIG_CAT);
    bf16_t* abuf = (bf16_t*)(ws + WS_BIG + BIG_A);
    bf16_t* pooled = (bf16_t*)(ws + WS_BIG + BIG_POOL);

    phase0(P, lds);
    asm volatile("s_waitcnt vmcnt(0)" ::: "memory");
    grid.sync();
    __builtin_amdgcn_fence(__ATOMIC_ACQUIRE, "agent");
    asm volatile("s_waitcnt vmcnt(0)" ::: "memory");
    bf16_t* hres = (bf16_t*)(ws + WS_H);
    norm_pass<false>(P.x, ubuf, P.norm1_g, mod0, 0, &P, hres);
    GSYNC(2);
    { Gemm g{ubuf, (const bf16_t*)(ws + WS_WIN), DM, DM, DM, (NT + NCTX) / 256, PW / 256, 0, 0, 0}; EpiProj E{pbuf, P.q_g, P.k_g}; gemm_phase(lds, g, E); }
    GSYNC(3);
    natten_phase(P, lds);
    dft_stage1(P, lds);
    GSYNC(4);
    dft_stage2(P, lds);
    GSYNC(5);
    { Gemm g{cat, (const bf16_t*)(ws + WS_WOUT), DM, DM, DM, NT / 256, DM / 256, 0, 0, 0}; EpiResT<true, true> E{hres, hres, mod0 + 2048, nullptr}; gemm_phase(lds, g, E); }
    GSYNC(6);
    norm_pass<true>(hres, ubuf, P.norm2_g, mod0, 1, nullptr);
    GSYNC(7);
    { Gemm g{ubuf, (const bf16_t*)(ws + WS_W1), DM, DM, DM, NT / 256, HID / 256, 0, 0, 0}; EpiAct E{abuf, HID}; gemm_phase(lds, g, E); }
    GSYNC(8);
    { Gemm g{abuf, (const bf16_t*)(ws + WS_W2), HID, HID, HID, NT / 256, DM / 256, 0, HID / 64, HID / 64}; EpiResT<true, true> E{hres, hres, mod0 + 5120, nullptr}; gemm_phase(lds, g, E); }
    GSYNC(9);
    pool_norm_fused(hres, P.norm1_g + DM, mod1, pooled, lds);
    GSYNC(11);
    { Gemm g{pooled, (const bf16_t*)(ws + WS_WPOOL), DM, 256, 256, NT / 256, 4, 512, 0, 0}; EpiResT<true, true> E{hres, hres, mod1 + 2048, P.pool_scale}; gemm_phase(lds, g, E); }
    GSYNC(12);
    norm_pass<true>(hres, ubuf, P.norm2_g + DM, mod1, 1, nullptr);
    GSYNC(13);
    { Gemm g{ubuf, (const bf16_t*)(ws + WS_W1) + (size_t)HID * DM, DM, DM, DM, NT / 256, HID / 256, 0, 0, 0}; EpiAct E{abuf, HID}; gemm_phase(lds, g, E); }
    GSYNC(14);
    { Gemm g{abuf, (const bf16_t*)(ws + WS_W2) + (size_t)DM * HID, HID, HID, HID, NT / 256, DM / 256, 0, HID / 64, HID / 64}; EpiResT<true, false> E{hres, P.out, mod1 + 5120, nullptr}; gemm_phase(lds, g, E); }
}

extern "C" void kernel_launch(void* const* d_in, const int* in_sizes, int n_in, void* d_out, int out_size, void* d_ws, size_t ws_size, hipStream_t stream) {
    static int grid_blocks = 0;
    if (grid_blocks == 0) {
        if (n_in != 18 || out_size != NT * DM || ws_size < WS_END) { fprintf(stderr, "kernel_launch: unexpected shapes (n_in %d out %d ws %zu need %zu)\n", n_in, out_size, ws_size, (size_t)WS_END); grid_blocks = -1; return; }
        int dev = 0, cus = 0, per_cu = 0;
        (void)hipGetDevice(&dev);
        (void)hipDeviceGetAttribute(&cus, hipDeviceAttributeMultiprocessorCount, dev);
        if (hipFuncSetAttribute((const void*)fwd_megakernel, hipFuncAttributeMaxDynamicSharedMemorySize, LDS_BYTES) != hipSuccess) { fprintf(stderr, "kernel_launch: hipFuncSetAttribute failed\n"); grid_blocks = -1; return; }
        if (hipOccupancyMaxActiveBlocksPerMultiprocessor(&per_cu, (const void*)fwd_megakernel, 512, LDS_BYTES) != hipSuccess || per_cu < 1) { fprintf(stderr, "kernel_launch: occupancy query failed (%d)\n", per_cu); (void)hipGetLastError(); per_cu = 1; }
        grid_blocks = cus * 1;
        (void)per_cu;
    }
    if (grid_blocks < 0) return;
    Params p{};
    p.x = (const float*)d_in[0]; p.c = (const float*)d_in[1]; p.ctx = (const float*)d_in[2]; p.c_ctx = (const float*)d_in[3]; p.w_mod = (const float*)d_in[4]; p.b_mod = (const float*)d_in[5];
    p.norm1_g = (const float*)d_in[6]; p.norm2_g = (const float*)d_in[7]; p.w_in = (const float*)d_in[8]; p.w_four = (const float*)d_in[9]; p.q_g = (const float*)d_in[10]; p.k_g = (const float*)d_in[11];
    p.rpb = (const float*)d_in[12]; p.w_out = (const float*)d_in[13]; p.w_pool = (const float*)d_in[14]; p.pool_scale = (const float*)d_in[15]; p.w_mlp1 = (const float*)d_in[16]; p.w_mlp2 = (const float*)d_in[17];
    p.out = (float*)d_out; p.ws = (unsigned char*)d_ws;
    if (hipMemsetAsync((char*)d_ws + WS_CTL, 0, 16384, stream) != hipSuccess) { fprintf(stderr, "kernel_launch: memset failed\n"); return; }
    void* args[] = {&p};
    hipError_t e = hipLaunchCooperativeKernel((const void*)fwd_megakernel, dim3(grid_blocks), dim3(512), args, LDS_BYTES, stream);
    if (e != hipSuccess) fprintf(stderr, "kernel_launch: cooperative launch failed: %s (grid %d)\n", hipGetErrorString(e), grid_blocks);
}
```

```cpp
#include <hip/hip_runtime.h>
#include <hip/hip_cooperative_groups.h>
#include <cstdio>
namespace cg = cooperative_groups;

#define LAS __attribute__((address_space(3)))
typedef unsigned short bf16_t;
typedef short bf16x8 __attribute__((ext_vector_type(8)));
typedef short s16x4 __attribute__((ext_vector_type(4)));
typedef float f32x4 __attribute__((ext_vector_type(4)));
typedef unsigned u32x4 __attribute__((ext_vector_type(4)));
typedef unsigned u32x2 __attribute__((ext_vector_type(2)));

constexpr int DM = 1024, NB = 4, SEQ = 8192, NT = NB * SEQ, CTXL = 256, NCTX = NB * CTXL, HID = 4096, NMOD = 6 * DM;
constexpr int PW = 2048;
constexpr int LDS_BYTES = 139264;

constexpr size_t al256(size_t x) { return (x + 255) & ~(size_t)255; }
constexpr size_t WS_CTL = 0;
constexpr size_t WS_MOD0 = 16384;
constexpr size_t WS_MOD1 = WS_MOD0 + al256((size_t)NB * NMOD * 4);
constexpr size_t WS_MODC = WS_MOD1 + al256((size_t)NB * NMOD * 4);
constexpr size_t WS_WIN = WS_MODC + al256(2048 * 4);
constexpr size_t WS_WOUT = WS_WIN + (size_t)PW * DM * 2;
constexpr size_t WS_W1 = WS_WOUT + (size_t)DM * DM * 2;
constexpr size_t WS_W2 = WS_W1 + (size_t)2 * HID * DM * 2;
constexpr size_t WS_WPOOL = WS_W2 + (size_t)2 * HID * DM * 2;
constexpr size_t WS_D1C = WS_WPOOL + (size_t)DM * 256 * 2;
constexpr size_t WS_D1S = WS_D1C + 128 * 128 * 2;
constexpr size_t WS_D2 = WS_D1S + 128 * 128 * 2;
constexpr size_t WS_U = WS_D2 + 64 * 128 * 2;
constexpr size_t WS_BIG = WS_U + (size_t)(NT + NCTX) * DM * 2;
constexpr size_t BIG_P = 0;
constexpr size_t BIG_S1 = BIG_P + (size_t)(NT + NCTX) * PW * 2;
constexpr size_t BIG_CAT = BIG_S1 + (size_t)NT * 1024 * 2;
constexpr size_t BIG_END = BIG_CAT + (size_t)NT * 1024 * 2;
constexpr size_t BIG_A = 0;
constexpr size_t BIG_POOL = 0;
constexpr size_t BIG_SIZE = BIG_END > (size_t)NT * HID * 2 ? BIG_END : (size_t)NT * HID * 2;
constexpr size_t WS_H = WS_BIG + BIG_SIZE;
constexpr size_t WS_END = WS_H + (size_t)NT * DM * 2;

struct Params {
    const float *x, *c, *ctx, *c_ctx, *w_mod, *b_mod, *norm1_g, *norm2_g, *w_in, *w_four, *q_g, *k_g, *rpb, *w_out, *w_pool, *pool_scale, *w_mlp1, *w_mlp2;
    float* out; unsigned char* ws;
};

typedef float f32x2 __attribute__((ext_vector_type(2)));
typedef __bf16 bf16x2v __attribute__((ext_vector_type(2)));
__device__ __forceinline__ unsigned cvt_pk_bf16(float lo, float hi) { const f32x2 f = {lo, hi}; const bf16x2v b = __builtin_convertvector(f, bf16x2v); return __builtin_bit_cast(unsigned, b); }
__device__ __forceinline__ float bf_lo(unsigned u) { return __uint_as_float(u << 16); }
__device__ __forceinline__ float bf_hi(unsigned u) { return __uint_as_float(u & 0xffff0000u); }
template <bool BF> __device__ __forceinline__ f32x4 ld4(const void* base, size_t idx) {
    if (BF) { const u32x2 v = *(const u32x2*)((const bf16_t*)base + idx); return (f32x4){bf_lo(v.x), bf_hi(v.x), bf_lo(v.y), bf_hi(v.y)}; }
    else return *(const f32x4*)((const float*)base + idx);
}
template <bool BF> __device__ __forceinline__ void st4(void* base, size_t idx, const f32x4 v) {
    if (BF) *(u32x2*)((bf16_t*)base + idx) = (u32x2){cvt_pk_bf16(v[0], v[1]), cvt_pk_bf16(v[2], v[3])};
    else *(f32x4*)((float*)base + idx) = v;
}
template <bool BF> __device__ __forceinline__ void ld8(const void* base, size_t idx, f32x4& a, f32x4& b) {
    if (BF) { const u32x4 v = *(const u32x4*)((const bf16_t*)base + idx); a = (f32x4){bf_lo(v.x), bf_hi(v.x), bf_lo(v.y), bf_hi(v.y)}; b = (f32x4){bf_lo(v.z), bf_hi(v.z), bf_lo(v.w), bf_hi(v.w)}; }
    else { a = __builtin_nontemporal_load((const f32x4*)((const float*)base + idx)); b = __builtin_nontemporal_load((const f32x4*)((const float*)base + idx + 4)); }
}
template <bool BF> __device__ __forceinline__ void st8(void* base, size_t idx, const f32x4 a, const f32x4 b) {
    if (BF) { u32x4 w; w.x = cvt_pk_bf16(a[0], a[1]); w.y = cvt_pk_bf16(a[2], a[3]); w.z = cvt_pk_bf16(b[0], b[1]); w.w = cvt_pk_bf16(b[2], b[3]); *(u32x4*)((bf16_t*)base + idx) = w; }
    else { __builtin_nontemporal_store(a, (f32x4*)((float*)base + idx)); __builtin_nontemporal_store(b, (f32x4*)((float*)base + idx + 4)); }
}
__device__ __forceinline__ int phys_row(int n, int mode) {
    const int L = n & 255, wc = L >> 6, bj = (L >> 5) & 1, j = L & 3;
    const int fq = mode ? ((L >> 2) & 3) : ((L >> 3) & 3), nn = mode ? ((L >> 4) & 1) : ((L >> 2) & 1);
    return (n & ~255) + 128 * bj + 32 * wc + 16 * nn + 4 * fq + j;
}

constexpr int BM = 256, BK = 64, HALF = 128, HTB = HALF * BK * 2, NXCD = 8, WGM = 8;
__device__ __forceinline__ int lds_byte(int r, int c) { const int st = (r >> 4) * 2 + (c >> 5), rr = r & 15, cc = c & 31, ob = rr * 64 + cc * 2; return st * 1024 + (ob ^ (((ob >> 9) & 1) << 5)); }
__device__ __forceinline__ void stage_rc(int b, int& R, int& C) { const int st = b / 1024, sb = b % 1024, swz = sb ^ (((sb >> 9) & 1) << 5); R = (st >> 1) * 16 + swz / 64; C = (st & 1) * 32 + (swz % 64) / 2; }
struct Unit { int pm, pn; };
struct Gemm { const bf16_t* A; const bf16_t* Bt; int lda, ldb, K, nM, nN, a_pn_bytes, a_blk, b_blk; int a_nt = 0; };
__device__ __forceinline__ size_t blk_off(int row, int col, int nkt) { return ((size_t)(row >> 7) * nkt + (col >> 6)) * 16384 + lds_byte(row & 127, col & 63); }
struct StaticOrder {
    int nM, nN, nwg, G, c;
    __device__ void init(int nM_, int nN_, int G_, int c_) { nM = nM_; nN = nN_; nwg = nM * nN; G = G_; c = c_; }
    __device__ bool next(int i, Unit& u) const {
        const long L = (long)i * G + c; if (L >= nwg) return false;
        int wgid = (int)L; { const int q = nwg / NXCD, r = nwg % NXCD, xcd = wgid % NXCD, off = wgid / NXCD; wgid = (xcd < r ? xcd * (q + 1) : r * (q + 1) + (xcd - r) * q) + off; }
        const int nig = WGM * nN, gid = wgid / nig, fm = gid * WGM, gsz = (nM - fm) < WGM ? (nM - fm) : WGM;
        u.pm = fm + ((wgid % nig) % gsz); u.pn = (wgid % nig) / gsz; return true;
    }
};

template <class Epi>
__device__ __forceinline__ void gemm_phase(LAS unsigned char* lds, const Gemm g, const Epi& E) {
    const int tid = threadIdx.x, wid = __builtin_amdgcn_readfirstlane(tid >> 6), lane = tid & 63, wr = wid >> 2, wc = wid & 3, fr = lane & 15, fq = lane >> 4;
    const int K = g.K, nt = K / BK;
    StaticOrder S; S.init(g.nM, g.nN, (int)gridDim.x, (int)blockIdx.x);
    unsigned voffA[2], voffB[2];
#pragma unroll
    for (int i = 0; i < 2; ++i) { int R, C; stage_rc(tid * 16 + i * 8192, R, C); voffA[i] = g.a_blk ? (unsigned)(tid * 16 + i * 8192) : (unsigned)(R * g.lda + C) * 2u; voffB[i] = g.b_blk ? (unsigned)(tid * 16 + i * 8192) : (unsigned)(R * g.ldb + C) * 2u; }
    const size_t kstepA = g.a_blk ? (size_t)16384 : (size_t)(BK * 2), kstepB = g.b_blk ? (size_t)16384 : (size_t)(BK * 2);
    const size_t hstepA = g.a_blk ? (size_t)g.a_blk * 16384 : (size_t)HALF * g.lda * 2, hstepB = g.b_blk ? (size_t)g.b_blk * 16384 : (size_t)HALF * g.ldb * 2;
    const size_t tstepA = 2 * hstepA, tstepB = 2 * hstepB;
    const unsigned ldsw = (unsigned)wid * 1024u;
    const int aoff = lds_byte(wr * 64 + fr, fq * 8), boff = lds_byte(wc * 32 + fr, fq * 8);
#define G_SA(b, h) (((b) * 2 + (h)) * HTB)
#define G_SB(b, h) ((4 + (b) * 2 + (h)) * HTB)
#define G_STAGE_A(bufoff, gbase, voff) do { if (g.a_nt) { _Pragma("unroll") for (int _i = 0; _i < 2; ++_i) \
        __builtin_amdgcn_global_load_lds((const unsigned*)((const char*)(gbase) + (voff)[_i]), (LAS unsigned*)(lds + (bufoff) + ldsw + _i * 8192), 16, 0, 2); } else { _Pragma("unroll") for (int _i = 0; _i < 2; ++_i) \
        __builtin_amdgcn_global_load_lds((const unsigned*)((const char*)(gbase) + (voff)[_i]), (LAS unsigned*)(lds + (bufoff) + ldsw + _i * 8192), 16, 0, 0); } } while (0)
#define G_STAGE(bufoff, gbase, voff) do { _Pragma("unroll") for (int _i = 0; _i < 2; ++_i) \
        __builtin_amdgcn_global_load_lds((const unsigned*)((const char*)(gbase) + (voff)[_i]), (LAS unsigned*)(lds + (bufoff) + ldsw + _i * 8192), 16, 0, 0); } while (0)
#define G_LDA(dst, b, h) do { _Pragma("unroll") for (int m = 0; m < 4; ++m) _Pragma("unroll") for (int k = 0; k < 2; ++k) dst[m][k] = *(const LAS bf16x8*)(lds + G_SA(b, h) + aoff + m * 2048 + k * 1024); } while (0)
#define G_LDB(dst, b, h) do { _Pragma("unroll") for (int n = 0; n < 2; ++n) _Pragma("unroll") for (int k = 0; k < 2; ++k) dst[n][k] = *(const LAS bf16x8*)(lds + G_SB(b, h) + boff + n * 2048 + k * 1024); } while (0)
#define G_MMA(ai, bj, At, Bt) do { __builtin_amdgcn_s_setprio(1); _Pragma("unroll") for (int m = 0; m < 4; ++m) _Pragma("unroll") for (int n = 0; n < 2; ++n) _Pragma("unroll") for (int k = 0; k < 2; ++k) \
        acc[ai][bj][m][n] = __builtin_amdgcn_mfma_f32_16x16x32_bf16(Bt[n][k], At[m][k], acc[ai][bj][m][n], 0, 0, 0); __builtin_amdgcn_s_setprio(0); } while (0)
#define G_WAIT_V(n) asm volatile("s_waitcnt vmcnt(" #n ")" ::: "memory")
#define G_WAIT_L(n) asm volatile("s_waitcnt lgkmcnt(" #n ")" ::: "memory")
#define G_BAR __builtin_amdgcn_s_barrier()
#define G_SCHED __builtin_amdgcn_sched_barrier(0)
    Unit cur, nxt; int ui = 0;
    if (!S.next(0, cur)) return;
    f32x4 acc[2][2][4][2];
#pragma unroll
    for (int a = 0; a < 2; ++a)
#pragma unroll
        for (int b = 0; b < 2; ++b)
#pragma unroll
            for (int m = 0; m < 4; ++m)
#pragma unroll
                for (int n = 0; n < 2; ++n) acc[a][b][m][n] = (f32x4){0.f, 0.f, 0.f, 0.f};
    bf16x8 At[4][2], B0[2][2], B1[2][2];
    const char* cA = (const char*)g.A + (size_t)cur.pm * tstepA + (size_t)cur.pn * g.a_pn_bytes; const char* cB = (const char*)g.Bt + (size_t)cur.pn * tstepB;
    G_STAGE(G_SB(0, 0), cB, voffB); G_STAGE_A(G_SA(0, 0), cA, voffA); G_STAGE(G_SB(0, 1), cB + hstepB, voffB); G_STAGE_A(G_SA(0, 1), cA + hstepA, voffA);
    if (wr == 1) G_BAR;
    G_WAIT_V(4); G_BAR;
    G_STAGE(G_SB(1, 0), cB + kstepB, voffB); G_STAGE_A(G_SA(1, 0), cA + kstepA, voffA); G_STAGE(G_SB(1, 1), cB + hstepB + kstepB, voffB);
    G_WAIT_V(6); G_BAR;
    for (;;) {
        const bool has_next = S.next(ui + 1, nxt);
        const char* nA = has_next ? (const char*)g.A + (size_t)nxt.pm * tstepA + (size_t)nxt.pn * g.a_pn_bytes : cA; const char* nB = has_next ? (const char*)g.Bt + (size_t)nxt.pn * tstepB : cB;
        for (int t = 0; t < nt; t += 2) {
            const bool last = (t == nt - 2);
            const char* a1 = cA + (size_t)(t + 1) * kstepA;
            const char* a2 = last ? nA : cA + (size_t)(t + 2) * kstepA; const char* b2 = last ? nB : cB + (size_t)(t + 2) * kstepB;
            const char* a3 = a2 + kstepA; const char* b3 = b2 + kstepB;
            G_LDB(B0, 0, 0); G_SCHED; G_LDA(At, 0, 0); G_STAGE_A(G_SA(1, 1), a1 + hstepA, voffA);
            G_WAIT_L(8); G_BAR; G_WAIT_L(0); G_MMA(0, 0, At, B0); G_BAR; G_SCHED;
            G_LDB(B1, 0, 1); G_STAGE(G_SB(0, 0), b2, voffB);
            G_BAR; G_WAIT_L(0); G_MMA(0, 1, At, B1); G_BAR;
            G_LDA(At, 0, 1); G_STAGE_A(G_SA(0, 0), a2, voffA);
            G_BAR; G_WAIT_L(0); G_MMA(1, 0, At, B0); G_BAR; G_SCHED;
            G_STAGE(G_SB(0, 1), b2 + hstepB, voffB);
            G_WAIT_V(6); G_BAR; G_MMA(1, 1, At, B1); G_BAR;
            G_LDB(B0, 1, 0); G_SCHED; G_LDA(At, 1, 0); G_STAGE_A(G_SA(0, 1), a2 + hstepA, voffA);
            G_WAIT_L(8); G_BAR; G_WAIT_L(0); G_MMA(0, 0, At, B0); G_BAR; G_SCHED;
            G_LDB(B1, 1, 1); G_STAGE(G_SB(1, 0), b3, voffB);
            G_BAR; G_WAIT_L(0); G_MMA(0, 1, At, B1); G_BAR;
            G_LDA(At, 1, 1); G_STAGE_A(G_SA(1, 0), a3, voffA);
            G_BAR; G_WAIT_L(0); G_MMA(1, 0, At, B0); G_BAR; G_SCHED;
            G_STAGE(G_SB(1, 1), b3 + hstepB, voffB);
            G_WAIT_V(6); G_BAR; G_MMA(1, 1, At, B1); G_BAR;
        }
        E(acc, cur, wr, wc, fr, fq);
        if (!has_next) break;
#pragma unroll
        for (int a = 0; a < 2; ++a)
#pragma unroll
            for (int b = 0; b < 2; ++b)
#pragma unroll
                for (int m = 0; m < 4; ++m)
#pragma unroll
                    for (int n = 0; n < 2; ++n) acc[a][b][m][n] = (f32x4){0.f, 0.f, 0.f, 0.f};
        cur = nxt; cA = nA; cB = nB; ++ui;
    }
    G_WAIT_V(0);
    if (wr == 0) G_BAR;
    G_BAR;
#undef G_SA
#undef G_SB
#undef G_STAGE
#undef G_STAGE_A
#undef G_LDA
#undef G_LDB
#undef G_MMA
#undef G_WAIT_V
#undef G_WAIT_L
#undef G_BAR
#undef G_SCHED
}

__device__ __forceinline__ void store16_bf16(bf16_t* dst, const float (&v)[16]) {
    u32x4 w0, w1;
    w0.x = cvt_pk_bf16(v[0], v[1]); w0.y = cvt_pk_bf16(v[2], v[3]); w0.z = cvt_pk_bf16(v[4], v[5]); w0.w = cvt_pk_bf16(v[6], v[7]);
    w1.x = cvt_pk_bf16(v[8], v[9]); w1.y = cvt_pk_bf16(v[10], v[11]); w1.z = cvt_pk_bf16(v[12], v[13]); w1.w = cvt_pk_bf16(v[14], v[15]);
    *(u32x4*)dst = w0; *(u32x4*)(dst + 8) = w1;
}
__device__ __forceinline__ void store8_bf16(bf16_t* dst, const f32x4 a, const f32x4 b) {
    u32x4 w; w.x = cvt_pk_bf16(a[0], a[1]); w.y = cvt_pk_bf16(a[2], a[3]); w.z = cvt_pk_bf16(b[0], b[1]); w.w = cvt_pk_bf16(b[2], b[3]);
    *(u32x4*)dst = w;
}
__device__ __forceinline__ void store8_bf16_nt(bf16_t* dst, const f32x4 a, const f32x4 b) {
    u32x4 w; w.x = cvt_pk_bf16(a[0], a[1]); w.y = cvt_pk_bf16(a[2], a[3]); w.z = cvt_pk_bf16(b[0], b[1]); w.w = cvt_pk_bf16(b[2], b[3]);
    __builtin_nontemporal_store(w, (u32x4*)dst);
}
struct EpiProj {
    bf16_t* P; const float* qg; const float* kg;
    __device__ __forceinline__ void operator()(const f32x4 (&acc)[2][2][4][2], const Unit& u, int wr, int wc, int fr, int fq) const {
        const int row0 = u.pm * BM + wr * 64 + fr, col0 = u.pn * BM + wc * 64 + fq * 8;
        const bool hn = (u.pn >= 2 && u.pn < 6);
        const float qs = (u.pn < 4) ? 0.18033688011112042f : 1.0f;
        f32x4 gv[2][2];
        if (hn) { const float* gp = (u.pn < 4 ? qg : kg) + fq * 8;
#pragma unroll
            for (int bj = 0; bj < 2; ++bj)
#pragma unroll
                for (int n = 0; n < 2; ++n) gv[bj][n] = *(const f32x4*)(gp + 32 * bj + 4 * n); }
#pragma unroll
        for (int ai = 0; ai < 2; ++ai)
#pragma unroll
            for (int m = 0; m < 4; ++m) {
                f32x4 v[2][2];
#pragma unroll
                for (int bj = 0; bj < 2; ++bj)
#pragma unroll
                    for (int n = 0; n < 2; ++n) v[bj][n] = acc[ai][bj][m][n];
                if (hn) {
                    float ss = 0.f;
#pragma unroll
                    for (int bj = 0; bj < 2; ++bj)
#pragma unroll
                        for (int n = 0; n < 2; ++n) ss += v[bj][n][0] * v[bj][n][0] + v[bj][n][1] * v[bj][n][1] + v[bj][n][2] * v[bj][n][2] + v[bj][n][3] * v[bj][n][3];
                    ss += __shfl_xor(ss, 16); ss += __shfl_xor(ss, 32);
                    const float rs = rsqrtf(ss * (1.0f / 64.0f) + 1e-6f);
#pragma unroll
                    for (int bj = 0; bj < 2; ++bj)
#pragma unroll
                        for (int n = 0; n < 2; ++n) v[bj][n] = v[bj][n] * (rs * qs) * gv[bj][n];
                }
                bf16_t* dst = P + (size_t)(row0 + ai * HALF + m * 16) * PW + col0;
                store8_bf16(dst, v[0][0], v[0][1]); store8_bf16(dst + 32, v[1][0], v[1][1]);
            }
    }
};
struct EpiAct {
    bf16_t* O; int ldo;
    __device__ __forceinline__ void operator()(const f32x4 (&acc)[2][2][4][2], const Unit& u, int wr, int wc, int fr, int fq) const {
        const int row0 = u.pm * BM + wr * 64 + fr, col0 = u.pn * BM + wc * 64 + fq * 8;
#pragma unroll
        for (int ai = 0; ai < 2; ++ai)
#pragma unroll
            for (int m = 0; m < 4; ++m) {
                const int row = row0 + ai * HALF + m * 16;
#pragma unroll
                for (int bj = 0; bj < 2; ++bj) { f32x4 a = acc[ai][bj][m][0], b = acc[ai][bj][m][1];
                    bf16_t* dst = (bf16_t*)((char*)O + blk_off(row, col0 + 32 * bj, ldo / 64));
#pragma unroll
                    for (int j = 0; j < 4; ++j) { const float ra = fmaxf(a[j], 0.f), rb = fmaxf(b[j], 0.f); a[j] = ra * ra; b[j] = rb * rb; }
                    store8_bf16_nt(dst, a, b); }
            }
    }
};
template <bool RB, bool OB> struct EpiResT {
    const void* res; void* out; const float* gate; const float* cscale;
    __device__ __forceinline__ void operator()(const f32x4 (&acc)[2][2][4][2], const Unit& u, int wr, int wc, int fr, int fq) const {
        const int row0 = u.pm * BM + wr * 64 + fr, col0 = u.pn * BM + wc * 64 + fq * 8;
        const int b = u.pm >> 5;
        f32x4 gv[2][2];
#pragma unroll
        for (int bj = 0; bj < 2; ++bj)
#pragma unroll
            for (int n = 0; n < 2; ++n) { f32x4 t = *(const f32x4*)(gate + (size_t)b * NMOD + col0 + 32 * bj + 4 * n);
                if (cscale) { const f32x4 s = *(const f32x4*)(cscale + col0 + 32 * bj + 4 * n); t = t * s; }
                gv[bj][n] = t; }
#pragma unroll
        for (int ai = 0; ai < 2; ++ai)
#pragma unroll
            for (int m = 0; m < 4; ++m) {
                const size_t off = (size_t)(row0 + ai * HALF + m * 16) * DM + col0;
#pragma unroll
                for (int bj = 0; bj < 2; ++bj) { f32x4 r0, r1; ld8<RB>(res, off + 32 * bj, r0, r1);
                    st8<OB>(out, off + 32 * bj, r0 + gv[bj][0] * acc[ai][bj][m][0], r1 + gv[bj][1] * acc[ai][bj][m][1]); }
            }
    }
};

__device__ void mod_task(const Params& P, int t, LAS float* sl) {
    const int tid = threadIdx.x, l = t / 96, n0 = (t % 96) * 64;
#pragma unroll
    for (int i = tid; i < 5 * 1024; i += 512) { const float v = (i < 4096) ? P.c[i] : P.c_ctx[i - 4096]; sl[i] = v / (1.0f + expf(-v)); }
    __syncthreads();
    const int kg = tid >> 6, ln = tid & 63;
    const float* w = P.w_mod + (size_t)l * DM * NMOD + n0 + ln;
    float a0 = 0.f, a1 = 0.f, a2 = 0.f, a3 = 0.f, a4 = 0.f;
#pragma unroll 8
    for (int k = kg * 128; k < kg * 128 + 128; ++k) { const float wv = __builtin_nontemporal_load(w + (size_t)k * NMOD); a0 += sl[k] * wv; a1 += sl[1024 + k] * wv; a2 += sl[2048 + k] * wv; a3 += sl[3072 + k] * wv; a4 += sl[4096 + k] * wv; }
    LAS float* red = sl + 5 * 1024;
    red[(kg * 5 + 0) * 64 + ln] = a0; red[(kg * 5 + 1) * 64 + ln] = a1; red[(kg * 5 + 2) * 64 + ln] = a2; red[(kg * 5 + 3) * 64 + ln] = a3; red[(kg * 5 + 4) * 64 + ln] = a4;
    __syncthreads();
    if (tid < 320) { const int r = tid >> 6, n = tid & 63; float s = 0.f;
        for (int g = 0; g < 8; ++g) s += red[(g * 5 + r) * 64 + n];
        s += P.b_mod[l * NMOD + n0 + n];
        float* modl = (float*)(P.ws + (l ? WS_MOD1 : WS_MOD0));
        if (r < 4) modl[r * NMOD + n0 + n] = s; else if (l == 0 && n0 + n < 2048) ((float*)(P.ws + WS_MODC))[n0 + n] = s; }
    __syncthreads();
}
__device__ void fold_win_task(const Params& P, int t, LAS float* sl) {
    const int tid = threadIdx.x, g = t >> 4, k0 = (t & 15) * 64;
    LAS float* wt = sl;
    LAS float* ctab = sl + 64 * 132;
    { const int r = tid >> 5, c4 = tid & 31;
#pragma unroll
        for (int i = 0; i < 4; ++i) { const f32x4 v = *(const f32x4*)(P.w_in + (size_t)(k0 + r + 16 * i) * PW + g * 128 + c4 * 4); LAS float* d = wt + (r + 16 * i) * 132 + c4 * 4; d[0] = v[0]; d[1] = v[1]; d[2] = v[2]; d[3] = v[3]; } }
    if (tid < 128) ctab[tid] = cospif((float)tid * (1.0f / 64.0f));
    __syncthreads();
    const int jj = tid & 127, kq = tid >> 7;
    float acc[16];
#pragma unroll
    for (int i = 0; i < 16; ++i) acc[i] = 0.f;
    const int mul = (jj <= 64) ? jj : (jj - 64), sub = (jj <= 64) ? 0 : 32;
    for (int c = 0; c < 128; c += 4) {
        const float d0 = ctab[(mul * c - sub) & 127], d1 = ctab[(mul * (c + 1) - sub) & 127], d2 = ctab[(mul * (c + 2) - sub) & 127], d3 = ctab[(mul * (c + 3) - sub) & 127];
#pragma unroll
        for (int i = 0; i < 16; ++i) { const f32x4 w = *(const LAS f32x4*)(wt + (kq * 16 + i) * 132 + c); acc[i] += w[0] * d0 + w[1] * d1 + w[2] * d2 + w[3] * d3; }
    }
    bf16_t* dst = (bf16_t*)(P.ws + WS_WIN) + (size_t)phys_row(g * 128 + jj, 0) * DM + k0 + kq * 16;
    store16_bf16(dst, acc);
    __syncthreads();
}
__device__ void fold_wout_task(const Params& P, int t, LAS float* sl) {
    const int tid = threadIdx.x, g = t >> 4, d0 = (t & 15) * 64;
    LAS float* wfp = sl;
    LAS float* wo = sl + 128 * 128;
    const float* base = P.w_four + (size_t)g * 128 * 128;
#pragma unroll 8
    for (int idx = tid; idx < 128 * 128; idx += 512) { const int jj = idx >> 7, e = idx & 127; float v;
        if (jj == 0 || jj == 64) v = base[jj * 128 + e];
        else if (jj < 64) v = base[jj * 128 + e] + base[(128 - jj) * 128 + e];
        else { const int l = jj - 64; v = base[(128 - l) * 128 + e] - base[l * 128 + e]; }
        wfp[idx] = v; }
    { const int r = tid >> 4, c4 = tid & 15;
#pragma unroll
        for (int i = 0; i < 4; ++i) { const f32x4 v = *(const f32x4*)(P.w_out + (size_t)(g * 128 + r + 32 * i) * DM + d0 + c4 * 4); LAS float* d = wo + (r + 32 * i) * 64 + c4 * 4; d[0] = v[0]; d[1] = v[1]; d[2] = v[2]; d[3] = v[3]; } }
    __syncthreads();
    const int dd = tid & 63, jq = tid >> 6;
    float acc[16];
#pragma unroll
    for (int i = 0; i < 16; ++i) acc[i] = 0.f;
    for (int e = 0; e < 128; e += 4) {
        const float w0 = wo[e * 64 + dd], w1 = wo[(e + 1) * 64 + dd], w2 = wo[(e + 2) * 64 + dd], w3 = wo[(e + 3) * 64 + dd];
#pragma unroll
        for (int i = 0; i < 16; ++i) { const f32x4 f = *(const LAS f32x4*)(wfp + (jq * 16 + i) * 128 + e); acc[i] += f[0] * w0 + f[1] * w1 + f[2] * w2 + f[3] * w3; }
    }
    bf16_t* dst = (bf16_t*)(P.ws + WS_WOUT) + (size_t)phys_row(d0 + dd, 0) * DM + g * 128 + jq * 16;
    store16_bf16(dst, acc);
    __syncthreads();
}
__device__ void conv_tile(const float* src, int ld, int k0, int n0, bf16_t* dst, int ldd, int kdst0, int ndst0, int mode, LAS float* sl, int blocked = 0) {
    const int tid = threadIdx.x;
    { const int r = tid >> 4, c4 = tid & 15;
        f32x4 v[4][2];
#pragma unroll
        for (int t = 0; t < 4; ++t)
#pragma unroll
            for (int i = 0; i < 2; ++i) v[t][i] = __builtin_nontemporal_load((const f32x4*)(src + (size_t)(k0 + r + 32 * i) * ld + n0 + t * 64 + c4 * 4));
#pragma unroll
        for (int t = 0; t < 4; ++t)
#pragma unroll
            for (int i = 0; i < 2; ++i) { LAS float* d = sl + t * (64 * 65) + (r + 32 * i) * 65 + c4 * 4; d[0] = v[t][i][0]; d[1] = v[t][i][1]; d[2] = v[t][i][2]; d[3] = v[t][i][3]; } }
    __syncthreads();
    { const int nn = tid >> 3, kc = tid & 7;
#pragma unroll
        for (int t = 0; t < 4; ++t) { float v[8];
#pragma unroll
            for (int i = 0; i < 8; ++i) v[i] = sl[t * (64 * 65) + (kc * 8 + i) * 65 + nn];
            u32x4 w; w.x = cvt_pk_bf16(v[0], v[1]); w.y = cvt_pk_bf16(v[2], v[3]); w.z = cvt_pk_bf16(v[4], v[5]); w.w = cvt_pk_bf16(v[6], v[7]);
            const int prow = phys_row(ndst0 + n0 + t * 64 + nn, mode), pcol = kdst0 + k0 + kc * 8;
            if (blocked) *(u32x4*)((char*)dst + blk_off(prow, pcol, ldd / 64)) = w; else *(u32x4*)(dst + (size_t)prow * ldd + pcol) = w; } }
    __syncthreads();
}
__device__ void dft_tab_task(const Params& P) {
    bf16_t* d1c = (bf16_t*)(P.ws + WS_D1C); bf16_t* d1s = (bf16_t*)(P.ws + WS_D1S); bf16_t* d2 = (bf16_t*)(P.ws + WS_D2);
    for (int idx = threadIdx.x; idx < 128 * 128; idx += 512) { const int ka = idx >> 7, a = idx & 127; const float ang = (float)((ka * a) & 127) * (1.0f / 64.0f);
        d1c[idx] = (bf16_t)(cvt_pk_bf16(cospif(ang), 0.f) & 0xffff); d1s[idx] = (bf16_t)(cvt_pk_bf16(-sinpif(ang), 0.f) & 0xffff); }
    for (int idx = threadIdx.x; idx < 64 * 128; idx += 512) { const int kb = idx >> 7, kk = idx & 127, bb = kk >> 1; const float ang = (float)((kb * bb) & 63) * (1.0f / 32.0f);
        const float v = ((kk & 1) ? sinpif(ang) : cospif(ang)) * (1.0f / 32.0f);
        d2[idx] = (bf16_t)(cvt_pk_bf16(v, 0.f) & 0xffff); }
}
__device__ void phase0(const Params& P, LAS unsigned char* lds) {
    LAS float* sl = (LAS float*)lds;
    constexpr int T_MOD = 192, T_FWIN = 64, T_FWOUT = 64, T_W1 = 512, T_W2 = 512, T_WIN = 96, T_WOUT = 32, T_POOL = 16, T_DFT = 1;
    constexpr int NTASK = T_MOD + T_FWIN + T_FWOUT + T_W1 + T_W2 + T_WIN + T_WOUT + T_POOL + T_DFT;
    unsigned* qhead = (unsigned*)(P.ws + WS_CTL) + 3600;
    volatile LAS unsigned* qslot = (volatile LAS unsigned*)(lds + LDS_BYTES - 8);
    for (;;) {
        __syncthreads();
        if (threadIdx.x == 0) *qslot = __hip_atomic_fetch_add(qhead, 1u, __ATOMIC_RELAXED, __HIP_MEMORY_SCOPE_AGENT);
        __syncthreads();
        const int t = (int)*qslot;
        if (t >= NTASK) break;
        int q = t;
        if (q < T_MOD) { mod_task(P, q, sl); continue; } q -= T_MOD;
        if (q < T_FWIN) { fold_win_task(P, q, sl); continue; } q -= T_FWIN;
        if (q < T_FWOUT) { fold_wout_task(P, q, sl); continue; } q -= T_FWOUT;
        if (q < T_W1) { const int l = q >> 8, r = q & 255, kt = r >> 4, ntile = r & 15;
            conv_tile(P.w_mlp1 + (size_t)l * DM * HID, HID, kt * 64, ntile * 256, (bf16_t*)(P.ws + WS_W1) + (size_t)l * HID * DM, DM, 0, 0, 0, sl); continue; } q -= T_W1;
        if (q < T_W2) { const int l = q >> 8, r = q & 255, kt = r >> 2, ntile = r & 3;
            conv_tile(P.w_mlp2 + (size_t)l * HID * DM, DM, kt * 64, ntile * 256, (bf16_t*)(P.ws + WS_W2) + (size_t)l * DM * HID, HID, 0, 0, 0, sl, 1); continue; } q -= T_W2;
        if (q < T_WIN) { const int kt = q / 6, ntile = q % 6;
            conv_tile(P.w_in, PW, kt * 64, 512 + ntile * 256, (bf16_t*)(P.ws + WS_WIN), DM, 0, 0, 0, sl); continue; } q -= T_WIN;
        if (q < T_WOUT) { const int kt = q >> 2, ntile = q & 3;
            conv_tile(P.w_out + (size_t)512 * DM, DM, kt * 64, ntile * 256, (bf16_t*)(P.ws + WS_WOUT), DM, 512, 0, 0, sl); continue; } q -= T_WOUT;
        if (q < T_POOL) { const int g = q >> 2, kt = q & 3;
            conv_tile(P.w_pool + (size_t)g * 256 * 256, 256, kt * 64, 0, (bf16_t*)(P.ws + WS_WPOOL), 256, 0, g * 256, 0, sl); continue; } q -= T_POOL;
        dft_tab_task(P);
    }
}

template <int NR, bool SB>
__device__ __forceinline__ void norm_rows(const void* src, size_t srow, bf16_t* dst, const f32x4 (&gs)[4], const f32x4 (&sh)[4], int lane, bf16_t* cpy = nullptr) {
    f32x4 v[NR][4]; float ss[NR];
#pragma unroll
    for (int r = 0; r < NR; ++r)
#pragma unroll
        for (int j = 0; j < 2; ++j) ld8<SB>(src, (srow + r) * DM + j * 512 + lane * 8, v[r][2 * j], v[r][2 * j + 1]);
#pragma unroll
    for (int r = 0; r < NR; ++r) { ss[r] = 0.f;
#pragma unroll
        for (int i = 0; i < 4; ++i) ss[r] += v[r][i][0] * v[r][i][0] + v[r][i][1] * v[r][i][1] + v[r][i][2] * v[r][i][2] + v[r][i][3] * v[r][i][3]; }
#pragma unroll
    for (int o = 32; o >= 1; o >>= 1)
#pragma unroll
        for (int r = 0; r < NR; ++r) ss[r] += __shfl_xor(ss[r], o);
#pragma unroll
    for (int r = 0; r < NR; ++r) { const float rs = rsqrtf(ss[r] * (1.0f / 1024.0f) + 1e-6f);
#pragma unroll
        for (int j = 0; j < 2; ++j) { const f32x4 a = v[r][2 * j] * rs * gs[2 * j] + sh[2 * j], b = v[r][2 * j + 1] * rs * gs[2 * j + 1] + sh[2 * j + 1];
            st8<true>(dst, (size_t)r * DM + j * 512 + lane * 8, a, b);
            if (cpy) st8<true>(cpy, (size_t)r * DM + j * 512 + lane * 8, v[r][2 * j], v[r][2 * j + 1]); } }
}
__device__ __forceinline__ void load_mod_vecs(const float* gn, const float* shift, const float* scale, f32x4 (&gs)[4], f32x4 (&sh)[4], int lane) {
#pragma unroll
    for (int i = 0; i < 4; ++i) { const int c = (i >> 1) * 512 + lane * 8 + (i & 1) * 4; const f32x4 g = *(const f32x4*)(gn + c), s = *(const f32x4*)(scale + c); gs[i] = g * (s + 1.0f); sh[i] = *(const f32x4*)(shift + c); }
}
template <bool SB>
__device__ __forceinline__ void norm_pass(const void* src, bf16_t* dst, const float* gn, const float* mod, int which, const Params* Pctx, bf16_t* cpy = nullptr) {
    int ltid_ = threadIdx.x; asm volatile("" : "+v"(ltid_));
    const int lane = ltid_ & 63, gw = blockIdx.x * 8 + (ltid_ >> 6), nw = gridDim.x * 8;
    f32x4 gs[4], sh[4];
    int curb = -1;
    for (int r = gw * 4; r < NT; r += nw * 4) {
        const int b = r >> 13;
        if (b != curb) { curb = b; load_mod_vecs(gn, mod + (size_t)b * NMOD + which * 3072, mod + (size_t)b * NMOD + which * 3072 + 1024, gs, sh, lane); }
        norm_rows<4, SB>(src, (size_t)r, dst + (size_t)r * DM, gs, sh, lane, cpy ? cpy + (size_t)r * DM : nullptr);
    }
    if (Pctx) {
        const float* modc = (const float*)(Pctx->ws + WS_MODC);
        load_mod_vecs(gn, modc, modc + 1024, gs, sh, lane);
        for (int r = gw; r < NCTX; r += nw) norm_rows<1, false>(Pctx->ctx, (size_t)r, dst + (size_t)(NT + r) * DM, gs, sh, lane);
    }
}

constexpr int ACT_PITCH = 260;
__device__ __forceinline__ void dft_load_tile(const bf16_t* src, size_t row_stride, LAS unsigned char* act) {
    const int tid = threadIdx.x, chunk = tid & 31, r0 = tid >> 5;
#pragma unroll
    for (int i = 0; i < 8; ++i) { const int r = r0 + 16 * i; const u32x4 v = *(const u32x4*)(src + (size_t)r * row_stride + chunk * 8);
        LAS u32x2* d = (LAS u32x2*)(act + r * (ACT_PITCH * 2) + chunk * 16); d[0] = (u32x2){v.x, v.y}; d[1] = (u32x2){v.z, v.w}; }
}
__device__ __forceinline__ bf16x8 dft_gather(const LAS unsigned char* act, int kc, int fq, int ch) {
    const LAS bf16_t* p = (const LAS bf16_t*)act + (kc * 32 + fq * 8) * ACT_PITCH + ch;
    bf16x8 r;
#pragma unroll
    for (int i = 0; i < 8; ++i) r[i] = (short)p[i * ACT_PITCH];
    return r;
}
__device__ void dft_stage1(const Params& P, LAS unsigned char* lds) {
    const int tid = threadIdx.x, wid = tid >> 6, lane = tid & 63, fr = lane & 15, fq = lane >> 4;
    LAS unsigned char* d1c = lds; LAS unsigned char* d1s = lds + 34816; LAS unsigned char* act = lds + 69632;
    __syncthreads();
#pragma unroll
    for (int id = tid; id < 2 * 2048; id += 512) { const int mtx = id >> 11, r = (id >> 4) & 127, ch = id & 15;
        const u32x4 v = *(const u32x4*)(P.ws + (mtx ? WS_D1S : WS_D1C) + r * 256 + ch * 16);
        *(LAS u32x4*)((mtx ? d1s : d1c) + r * 272 + ch * 16) = v; }
    const bf16_t* pbuf = (const bf16_t*)(P.ws + WS_BIG + BIG_P);
    bf16_t* s1 = (bf16_t*)(P.ws + WS_BIG + BIG_S1);
    for (int u = blockIdx.x; u < NB * 64 * 2; u += gridDim.x) {
        const int half = u & 1, bb = (u >> 1) & 63, b = u >> 7;
        __syncthreads();
        dft_load_tile(pbuf + ((size_t)b * SEQ + bb) * PW + half * 256, (size_t)64 * PW, act);
        __syncthreads();
#pragma unroll 1
        for (int cti = 0; cti < 2; ++cti) {
            const int ct = wid * 2 + cti;
            bf16x8 af[4];
#pragma unroll
            for (int kc = 0; kc < 4; ++kc) af[kc] = dft_gather(act, kc, fq, ct * 16 + fr);
            const int chg = half * 256 + ct * 16 + fq * 4;
#pragma unroll 1
            for (int kt = 0; kt < 8; ++kt) {
                f32x4 aR = (f32x4){0.f, 0.f, 0.f, 0.f}, aI = (f32x4){0.f, 0.f, 0.f, 0.f};
#pragma unroll
                for (int kc = 0; kc < 4; ++kc) {
                    const bf16x8 bc = *(const LAS bf16x8*)(d1c + (kt * 16 + fr) * 272 + (kc * 32 + fq * 8) * 2);
                    const bf16x8 bs = *(const LAS bf16x8*)(d1s + (kt * 16 + fr) * 272 + (kc * 32 + fq * 8) * 2);
                    aR = __builtin_amdgcn_mfma_f32_16x16x32_bf16(af[kc], bc, aR, 0, 0, 0);
                    aI = __builtin_amdgcn_mfma_f32_16x16x32_bf16(af[kc], bs, aI, 0, 0, 0);
                }
                const int ka = kt * 16 + fr;
                float sph, cph; sincospif((float)((ka * bb) & 8191) * (1.0f / 4096.0f), &sph, &cph);
                cph *= (1.0f / 32.0f); sph *= (1.0f / 32.0f);
                float re[4], im[4];
#pragma unroll
                for (int j = 0; j < 4; ++j) { const float x = aR[j], y = aI[j]; const float r0 = x * cph + y * sph, i0 = y * cph - x * sph;
                    const bool isq = ((chg + j) & 127) > 64; re[j] = isq ? -i0 : r0; im[j] = isq ? r0 : i0; }
                bf16_t* d = s1 + ((((size_t)b * 128 + ka) * 64 + bb) * 2) * 512 + chg;
                *(u32x2*)d = (u32x2){cvt_pk_bf16(re[0], re[1]), cvt_pk_bf16(re[2], re[3])};
                *(u32x2*)(d + 512) = (u32x2){cvt_pk_bf16(im[0], im[1]), cvt_pk_bf16(im[2], im[3])};
            }
        }
    }
    __syncthreads();
}
__device__ void dft_stage2(const Params& P, LAS unsigned char* lds) {
    const int tid = threadIdx.x, wid = tid >> 6, lane = tid & 63, fr = lane & 15, fq = lane >> 4;
    LAS unsigned char* d2 = lds; LAS unsigned char* act = lds + 17408;
    __syncthreads();
#pragma unroll
    for (int id = tid; id < 1024; id += 512) { const int r = id >> 4, ch = id & 15; *(LAS u32x4*)(d2 + r * 272 + ch * 16) = *(const u32x4*)(P.ws + WS_D2 + r * 256 + ch * 16); }
    const bf16_t* s1 = (const bf16_t*)(P.ws + WS_BIG + BIG_S1);
    bf16_t* cat = (bf16_t*)(P.ws + WS_BIG + BIG_CAT);
    for (int u = blockIdx.x; u < NB * 128 * 2; u += gridDim.x) {
        const int half = u & 1, ka = (u >> 1) & 127, b = u >> 8;
        __syncthreads();
        dft_load_tile(s1 + (((size_t)b * 128 + ka) * 128) * 512 + half * 256, 512, act);
        __syncthreads();
#pragma unroll 1
        for (int cti = 0; cti < 2; ++cti) {
            const int ct = wid * 2 + cti;
            bf16x8 af[4];
#pragma unroll
            for (int kc = 0; kc < 4; ++kc) af[kc] = dft_gather(act, kc, fq, ct * 16 + fr);
            f32x4 acc[4];
#pragma unroll
            for (int kt = 0; kt < 4; ++kt) acc[kt] = (f32x4){0.f, 0.f, 0.f, 0.f};
#pragma unroll
            for (int kt = 0; kt < 4; ++kt)
#pragma unroll
                for (int kc = 0; kc < 4; ++kc) {
                    const bf16x8 bv = *(const LAS bf16x8*)(d2 + (kt * 16 + fr) * 272 + (kc * 32 + fq * 8) * 2);
                    acc[kt] = __builtin_amdgcn_mfma_f32_16x16x32_bf16(af[kc], bv, acc[kt], 0, 0, 0);
                }
#pragma unroll
            for (int kt = 0; kt < 4; ++kt) { const int kb = kt * 16 + fr; const size_t tok = (size_t)b * SEQ + ka + 128 * kb;
                *(u32x2*)(cat + tok * 1024 + half * 256 + ct * 16 + fq * 4) = (u32x2){cvt_pk_bf16(acc[kt][0], acc[kt][1]), cvt_pk_bf16(acc[kt][2], acc[kt][3])}; }
        }
    }
    __syncthreads();
}

constexpr int VP = 160;
__device__ void natten_phase(const Params& P, LAS unsigned char* lds) {
    const int tid = threadIdx.x, wid = __builtin_amdgcn_readfirstlane(tid >> 6), lane = tid & 63, fr = lane & 15, fq = lane >> 4;
    LAS unsigned char* vimg = lds;
    LAS float* rpbs = (LAS float*)(lds + 832 * VP);
    const bf16_t* pbuf = (const bf16_t*)(P.ws + WS_BIG + BIG_P);
    bf16_t* cat = (bf16_t*)(P.ws + WS_BIG + BIG_CAT);
    const int upb = (NB * 8 * 64 + gridDim.x - 1) / gridDim.x;
    int lastbh = -1;
    for (int u = blockIdx.x * upb; u < min((int)(blockIdx.x + 1) * upb, NB * 8 * 64); ++u) {
        const int rp = u & 63, h = (u >> 6) & 7, b = u >> 9;
        const bool newbh = ((u >> 6) != lastbh); lastbh = u >> 6;
        const int rs0 = min(max(2 * rp - 4, 0), 120), rs1 = min(max(2 * rp - 3, 0), 120), nrows = rs1 - rs0 + 8;
        __syncthreads();
        {
            u32x4 tv[13];
            const int ch = tid & 7, r0 = tid >> 3;
            const bf16_t* vw = pbuf + ((size_t)b * SEQ + rs0 * 64 + r0) * PW + 1536 + h * 64 + ch * 8;
            const bf16_t* vc = pbuf + ((size_t)NT + b * CTXL + r0) * PW + 1536 + h * 64 + ch * 8;
#pragma unroll
            for (int i = 0; i < 8; ++i) tv[i] = *(const u32x4*)(vw + (size_t)i * 64 * PW);
            if (nrows == 9) tv[8] = *(const u32x4*)(vw + (size_t)8 * 64 * PW);
            if (newbh) {
#pragma unroll
                for (int i = 0; i < 4; ++i) tv[9 + i] = *(const u32x4*)(vc + (size_t)i * 64 * PW); }
#pragma unroll
            for (int i = 0; i < 8; ++i) *(LAS u32x4*)(vimg + (r0 + 64 * i) * VP + ch * 16) = tv[i];
            if (nrows == 9) *(LAS u32x4*)(vimg + (r0 + 512) * VP + ch * 16) = tv[8];
            if (newbh) {
#pragma unroll
                for (int i = 0; i < 4; ++i) *(LAS u32x4*)(vimg + (576 + r0 + 64 * i) * VP + ch * 16) = tv[9 + i]; }
        }
        if (newbh && tid < 465) rpbs[tid] = P.rpb[h * 465 + tid] * 1.44269504f;
        __syncthreads();
        const int r = 2 * rp + (wid >> 2), qt = wid & 3, c0 = (qt == 0) ? 0 : (qt == 1 ? 8 : (qt == 2 ? 24 : 32));
        const int rs = min(max(r - 4, 0), 120);
        const size_t qtok = (size_t)b * SEQ + r * 64 + qt * 16 + fr;
        const unsigned lofs = (unsigned)(fr * PW + fq * 8) * 2u;
        const char* qbase = (const char*)(pbuf + ((size_t)b * SEQ + r * 64 + qt * 16) * PW + 512 + h * 64);
        const char* kbase = (const char*)(pbuf + ((size_t)b * SEQ + rs * 64 + c0) * PW + 1024 + h * 64);
        const char* cbase = (const char*)(pbuf + ((size_t)NT + b * CTXL) * PW + 1024 + h * 64);
        const bf16x8 q0 = *(const bf16x8*)(qbase + lofs);
        const bf16x8 q1 = *(const bf16x8*)(qbase + 64 + lofs);
        f32x4 s[32];
#pragma unroll
        for (int t = 0; t < 16; ++t) {
            const unsigned toff = (unsigned)(((t >> 1) * 64 + (t & 1) * 16) * PW * 2);
            const bf16x8 k0 = *(const bf16x8*)(kbase + toff + lofs);
            const bf16x8 k1 = *(const bf16x8*)(kbase + toff + 64 + lofs);
            f32x4 a = (f32x4){0.f, 0.f, 0.f, 0.f};
            a = __builtin_amdgcn_mfma_f32_16x16x32_bf16(k0, q0, a, 0, 0, 0);
            s[t] = __builtin_amdgcn_mfma_f32_16x16x32_bf16(k1, q1, a, 0, 0, 0);
        }
#pragma unroll
        for (int t = 0; t < 16; ++t) {
            const unsigned toff = (unsigned)(t * 16 * PW * 2);
            const bf16x8 k0 = *(const bf16x8*)(cbase + toff + lofs);
            const bf16x8 k1 = *(const bf16x8*)(cbase + toff + 64 + lofs);
            f32x4 a = (f32x4){0.f, 0.f, 0.f, 0.f};
            a = __builtin_amdgcn_mfma_f32_16x16x32_bf16(k0, q0, a, 0, 0, 0);
            s[16 + t] = __builtin_amdgcn_mfma_f32_16x16x32_bf16(k1, q1, a, 0, 0, 0);
        }
        const int cq = qt * 16 + fr, cst = min(max(cq - 8, 0), 48);
        const int vlo = cst - c0 - fq * 4;
        const LAS float* brow = rpbs + (rs - r + 7) * 31 + (15 + c0 + fq * 4 - cq);
        float mx = -1e30f;
#pragma unroll
        for (int t = 0; t < 16; ++t) {
#pragma unroll
            for (int j = 0; j < 4; ++j) { const int off = (t & 1) * 16 + j;
                const float v = ((unsigned)(off - vlo) < 16u) ? s[t][j] + brow[(t >> 1) * 31 + off] : -1e30f; s[t][j] = v; mx = fmaxf(mx, v); }
        }
#pragma unroll
        for (int t = 16; t < 32; ++t)
#pragma unroll
            for (int j = 0; j < 4; ++j) mx = fmaxf(mx, s[t][j]);
        mx = fmaxf(mx, __shfl_xor(mx, 16)); mx = fmaxf(mx, __shfl_xor(mx, 32));
        float sum = 0.f;
#pragma unroll
        for (int t = 0; t < 32; ++t)
#pragma unroll
            for (int j = 0; j < 4; ++j) { const float p = __builtin_amdgcn_exp2f(s[t][j] - mx); s[t][j] = p; sum += p; }
        sum += __shfl_xor(sum, 16); sum += __shfl_xor(sum, 32);
        f32x4 o[4];
#pragma unroll
        for (int dt = 0; dt < 4; ++dt) o[dt] = (f32x4){0.f, 0.f, 0.f, 0.f};
        const int trq = (lane >> 2) & 3, trp = lane & 3;
#pragma unroll
        for (int pi = 0; pi < 16; ++pi) {
            const int t0 = 2 * pi, t1 = 2 * pi + 1;
            int rb0, rb1;
            if (pi < 8) { rb0 = (rs + pi - rs0) * 64 + c0; rb1 = rb0 + 16; } else { rb0 = 576 + (t0 - 16) * 16; rb1 = rb0 + 16; }
            bf16x8 pf; { const unsigned a0 = cvt_pk_bf16(s[t0][0], s[t0][1]), a1 = cvt_pk_bf16(s[t0][2], s[t0][3]), a2 = cvt_pk_bf16(s[t1][0], s[t1][1]), a3 = cvt_pk_bf16(s[t1][2], s[t1][3]);
                u32x4 w = (u32x4){a0, a1, a2, a3}; pf = __builtin_bit_cast(bf16x8, w); }
#pragma unroll
            for (int dt = 0; dt < 4; ++dt) {
                const s16x4 v0 = __builtin_amdgcn_ds_read_tr16_b64_v4i16((LAS s16x4*)(vimg + (rb0 + fq * 4 + trq) * VP + (dt * 16 + trp * 4) * 2));
                const s16x4 v1 = __builtin_amdgcn_ds_read_tr16_b64_v4i16((LAS s16x4*)(vimg + (rb1 + fq * 4 + trq) * VP + (dt * 16 + trp * 4) * 2));
                bf16x8 vf; vf[0] = v0[0]; vf[1] = v0[1]; vf[2] = v0[2]; vf[3] = v0[3]; vf[4] = v1[0]; vf[5] = v1[1]; vf[6] = v1[2]; vf[7] = v1[3];
                o[dt] = __builtin_amdgcn_mfma_f32_16x16x32_bf16(vf, pf, o[dt], 0, 0, 0);
            }
        }
        const float inv = 1.0f / sum;
#pragma unroll
        for (int dt = 0; dt < 4; ++dt)
            *(u32x2*)(cat + qtok * 1024 + 512 + h * 64 + dt * 16 + fq * 4) = (u32x2){cvt_pk_bf16(o[dt][0] * inv, o[dt][1] * inv), cvt_pk_bf16(o[dt][2] * inv, o[dt][3] * inv)};
    }
    __syncthreads();
}

template <int HW>
__device__ __forceinline__ void pool_item(const bf16_t* u, bf16_t* pooled, int t, int chunk) {
    const int tl = t & (SEQ - 1);
    const bf16_t* base = u + (size_t)(t - tl) * DM + chunk * 8;
    float a[8];
#pragma unroll
    for (int i = 0; i < 8; ++i) a[i] = 0.f;
    u32x4 v[2 * HW];
#pragma unroll
    for (int d = 0; d < 2 * HW; ++d) { const int r = tl - HW + d, rc = min(max(r, 0), SEQ - 1); v[d] = *(const u32x4*)(base + (size_t)rc * DM); }
#pragma unroll
    for (int d = 0; d < 2 * HW; ++d) { const int r = tl - HW + d; const float w = (r >= 0 && r < SEQ) ? 1.0f : 0.0f;
        a[0] += w * bf_lo(v[d].x); a[1] += w * bf_hi(v[d].x); a[2] += w * bf_lo(v[d].y); a[3] += w * bf_hi(v[d].y); a[4] += w * bf_lo(v[d].z); a[5] += w * bf_hi(v[d].z); a[6] += w * bf_lo(v[d].w); a[7] += w * bf_hi(v[d].w); }
    const int lo = max(tl - HW, 0), hi = min(tl + HW, SEQ);
    const float ic = 1.0f / (float)(hi - lo);
    const u32x4 c = v[HW];
    u32x4 w; w.x = cvt_pk_bf16(a[0] * ic - bf_lo(c.x), a[1] * ic - bf_hi(c.x)); w.y = cvt_pk_bf16(a[2] * ic - bf_lo(c.y), a[3] * ic - bf_hi(c.y));
    w.z = cvt_pk_bf16(a[4] * ic - bf_lo(c.z), a[5] * ic - bf_hi(c.z)); w.w = cvt_pk_bf16(a[6] * ic - bf_lo(c.w), a[7] * ic - bf_hi(c.w));
    *(u32x4*)(pooled + (size_t)t * DM + chunk * 8) = w;
}
__device__ void pool_pass(const bf16_t* u, bf16_t* pooled) {
    const int lane = threadIdx.x & 63, gw = blockIdx.x * 8 + (threadIdx.x >> 6), nw = gridDim.x * 8;
    for (int wi = gw; wi < (NT / 2) * 4; wi += nw) {
        const int gi = wi & 3, t = (wi >> 2) * 2 + (lane >> 5), chunk = gi * 32 + (lane & 31);
        if (gi == 0) pool_item<1>(u, pooled, t, chunk); else if (gi == 1) pool_item<2>(u, pooled, t, chunk); else if (gi == 2) pool_item<4>(u, pooled, t, chunk); else pool_item<8>(u, pooled, t, chunk);
    }
}

template <int HW>
__device__ __forceinline__ void pool_from_lds(const LAS unsigned char* U, bf16_t* pooled, int t0, int tl0, int tbase, int chunk) {
#pragma unroll 2
    for (int i = 0; i < 8; ++i) {
        const int t = tbase + i, tl = tl0 + t;
        float a[8];
#pragma unroll
        for (int k = 0; k < 8; ++k) a[k] = 0.f;
#pragma unroll
        for (int d = 0; d < 2 * HW; ++d) { const int r = tl - HW + d; const float w = (r >= 0 && r < SEQ) ? 1.0f : 0.0f;
            const u32x4 v = *(const LAS u32x4*)(U + (t + 8 - HW + d) * 2048 + chunk * 16);
            a[0] += w * bf_lo(v.x); a[1] += w * bf_hi(v.x); a[2] += w * bf_lo(v.y); a[3] += w * bf_hi(v.y); a[4] += w * bf_lo(v.z); a[5] += w * bf_hi(v.z); a[6] += w * bf_lo(v.w); a[7] += w * bf_hi(v.w); }
        const int lo = max(tl - HW, 0), hi = min(tl + HW, SEQ);
        const float ic = 1.0f / (float)(hi - lo);
        const u32x4 c = *(const LAS u32x4*)(U + (t + 8) * 2048 + chunk * 16);
        u32x4 w; w.x = cvt_pk_bf16(a[0] * ic - bf_lo(c.x), a[1] * ic - bf_hi(c.x)); w.y = cvt_pk_bf16(a[2] * ic - bf_lo(c.y), a[3] * ic - bf_hi(c.y));
        w.z = cvt_pk_bf16(a[4] * ic - bf_lo(c.z), a[5] * ic - bf_hi(c.z)); w.w = cvt_pk_bf16(a[6] * ic - bf_lo(c.w), a[7] * ic - bf_hi(c.w));
        *(u32x4*)(pooled + (size_t)(t0 + t) * DM + chunk * 8) = w;
    }
}
__device__ void pool_norm_fused(const bf16_t* h, const float* gn, const float* mod, bf16_t* pooled, LAS unsigned char* lds) {
    int tid = threadIdx.x; asm volatile("" : "+v"(tid));
    const int wid = tid >> 6, lane = tid & 63;
    for (int ck = blockIdx.x; ck < NT / 32; ck += gridDim.x) {
        const int t0 = ck * 32, b = t0 >> 13, tl0 = t0 & (SEQ - 1);
        f32x4 gs[4], sh[4];
        load_mod_vecs(gn, mod + (size_t)b * NMOD, mod + (size_t)b * NMOD + 1024, gs, sh, lane);
        __syncthreads();
#pragma unroll 1
        for (int rr = 0; rr < 6; rr += 2) {
            f32x4 v[2][4]; float ss[2];
#pragma unroll
            for (int q = 0; q < 2; ++q) { const int row = wid * 6 + rr + q, tl = min(max(tl0 - 8 + row, 0), SEQ - 1);
#pragma unroll
                for (int j = 0; j < 2; ++j) ld8<true>(h, ((size_t)b * SEQ + tl) * DM + j * 512 + lane * 8, v[q][2 * j], v[q][2 * j + 1]); }
#pragma unroll
            for (int q = 0; q < 2; ++q) { ss[q] = 0.f;
#pragma unroll
                for (int i = 0; i < 4; ++i) ss[q] += v[q][i][0] * v[q][i][0] + v[q][i][1] * v[q][i][1] + v[q][i][2] * v[q][i][2] + v[q][i][3] * v[q][i][3]; }
#pragma unroll
            for (int o = 32; o >= 1; o >>= 1) { ss[0] += __shfl_xor(ss[0], o); ss[1] += __shfl_xor(ss[1], o); }
#pragma unroll
            for (int q = 0; q < 2; ++q) { const float rs = rsqrtf(ss[q] * (1.0f / 1024.0f) + 1e-6f); const int row = wid * 6 + rr + q;
#pragma unroll
                for (int j = 0; j < 2; ++j) { const f32x4 a = v[q][2 * j] * rs * gs[2 * j] + sh[2 * j], c = v[q][2 * j + 1] * rs * gs[2 * j + 1] + sh[2 * j + 1];
                    u32x4 w; w.x = cvt_pk_bf16(a[0], a[1]); w.y = cvt_pk_bf16(a[2], a[3]); w.z = cvt_pk_bf16(c[0], c[1]); w.w = cvt_pk_bf16(c[2], c[3]);
                    *(LAS u32x4*)(lds + row * 2048 + (j * 512 + lane * 8) * 2) = w; } }
        }
        __syncthreads();
        const int g = wid & 3, chunk = g * 32 + (lane & 31), tbase = (wid >> 2) * 16 + (lane >> 5) * 8;
        if (g == 0) pool_from_lds<1>(lds, pooled, t0, tl0, tbase, chunk); else if (g == 1) pool_from_lds<2>(lds, pooled, t0, tl0, tbase, chunk);
        else if (g == 2) pool_from_lds<4>(lds, pooled, t0, tl0, tbase, chunk); else pool_from_lds<8>(lds, pooled, t0, tl0, tbase, chunk);
    }
    __syncthreads();
}

#define XB_TMO      128
#define XB_XCNT(j)  (256  + 64 * (j))
#define XB_XSUB(j)  (1280 + 64 * (j))
#define XB_XGEN(j)  (2304 + 64 * (j))
#define XB_TOP      3328
#define XB_TOPGEN   3392
#define XCD_BAR_WORDS 3456
#define XB_SPIN_CAP (1u << 18)
__device__ __forceinline__ unsigned xb_ld(unsigned* p)              { return __hip_atomic_load(p, __ATOMIC_RELAXED, __HIP_MEMORY_SCOPE_AGENT); }
__device__ __forceinline__ unsigned xb_add(unsigned* p, unsigned v) { return __hip_atomic_fetch_add(p, v, __ATOMIC_RELAXED, __HIP_MEMORY_SCOPE_AGENT); }
__device__ __forceinline__ unsigned xb_xcc_id() { return (unsigned)__builtin_amdgcn_s_getreg((3 << 11) | 20) & 0xFu; }
#define XB_SPIN(cond, bar) do { unsigned _sp = 0; while (cond) { __builtin_amdgcn_s_sleep(1); \
    if ((++_sp & 255u) == 0u) { if (xb_ld(&(bar)[XB_TMO])) break; if (_sp > XB_SPIN_CAP) { atomicAdd(&(bar)[XB_TMO], 1u); break; } } } } while (0)
struct XcdBarrier { unsigned* bar; unsigned x; volatile LAS unsigned* st; };
__device__ __forceinline__ XcdBarrier xcd_barrier_post(unsigned* bar, volatile LAS unsigned* st) {
    XcdBarrier b; b.bar = bar; b.x = xb_xcc_id(); b.st = st;
    if (threadIdx.x == 0) (void)xb_add(&bar[XB_XCNT(b.x)], 1u);
    return b;
}
__device__ __forceinline__ void xcd_barrier_complete(unsigned* bar, unsigned x, unsigned& nloc, unsigned& nx) {
    const unsigned G = gridDim.x * gridDim.y * gridDim.z;
    unsigned sum, cnt, mine, sp = 0u;
    for (;;) {
        sum = 0u; cnt = 0u; mine = 0u;
#pragma unroll
        for (unsigned j = 0; j < 16; ++j) { const unsigned c = xb_ld(&bar[XB_XCNT(j)]); sum += c; cnt += (c > 0u) ? 1u : 0u; mine = (j == x) ? c : mine; }
        if (sum == G) break;
        __builtin_amdgcn_s_sleep(1);
        if ((++sp & 255u) == 0u) { if (xb_ld(&bar[XB_TMO])) break; if (sp > XB_SPIN_CAP) { atomicAdd(&bar[XB_TMO], 1u); break; } }
    }
    nloc = mine > 0u ? mine : 1u; nx = cnt > 0u ? cnt : 1u;
}
__device__ __forceinline__ void xcd_barrier(const XcdBarrier& b) {
    asm volatile("s_waitcnt vmcnt(0)" ::: "memory");
    __syncthreads();
    if (threadIdx.x == 0) {
        unsigned* bar = b.bar;
        __builtin_amdgcn_s_waitcnt(0);
        unsigned nloc = b.st[0], nx = b.st[1];
        if (nloc == 0u) { xcd_barrier_complete(bar, b.x, nloc, nx); b.st[0] = nloc; b.st[1] = nx; }
        const unsigned old = xb_add(&bar[XB_XSUB(b.x)], 1u);
        const unsigned gen = old / nloc;
        if (old + 1u == (gen + 1u) * nloc) {
            __builtin_amdgcn_fence(__ATOMIC_RELEASE, "agent");
            asm volatile("s_waitcnt vmcnt(0)" ::: "memory");
            const unsigned og = xb_add(&bar[XB_TOP], 1u);
            const unsigned tg = og / nx;
            if (og + 1u == (tg + 1u) * nx) xb_add(&bar[XB_TOPGEN], 1u);
            else XB_SPIN(xb_ld(&bar[XB_TOPGEN]) == tg, bar);
            __builtin_amdgcn_fence(__ATOMIC_ACQUIRE, "agent");
            xb_add(&bar[XB_XGEN(b.x)], 1u);
            asm volatile("s_waitcnt vmcnt(0)" ::: "memory");
        } else {
            XB_SPIN(xb_ld(&bar[XB_XGEN(b.x)]) == gen, bar);
            __builtin_amdgcn_fence(__ATOMIC_ACQUIRE, "agent");
            asm volatile("s_waitcnt vmcnt(0)" ::: "memory");
        }
    }
    __syncthreads();
}

__global__ void __launch_bounds__(512, 2) fwd_megakernel(Params P) {
    extern __shared__ __attribute__((aligned(16))) unsigned char shm[];
    LAS unsigned char* lds = (LAS unsigned char*)shm;
    cg::grid_group grid = cg::this_grid();
    volatile LAS unsigned* xst = (volatile LAS unsigned*)(lds + LDS_BYTES - 16);
    if (threadIdx.x == 0) { xst[0] = 0u; xst[1] = 0u; }
    __syncthreads();
    const XcdBarrier xb = xcd_barrier_post((unsigned*)(P.ws + WS_CTL), xst);
#define GSYNC(n) xcd_barrier(xb)
    unsigned char* ws = P.ws;
    const float* mod0 = (const float*)(ws + WS_MOD0); const float* mod1 = (const float*)(ws + WS_MOD1);
    bf16_t* ubuf = (bf16_t*)(ws + WS_U);
    bf16_t* pbuf = (bf16_t*)(ws + WS_BIG + BIG_P);
    bf16_t* cat = (bf16_t*)(ws + WS_BIG + BIG_CAT);
    bf16_t* abuf = (bf16_t*)(ws + WS_BIG + BIG_A);
    bf16_t* pooled = (bf16_t*)(ws + WS_BIG + BIG_POOL);

    phase0(P, lds);
    asm volatile("s_waitcnt vmcnt(0)" ::: "memory");
    grid.sync();
    __builtin_amdgcn_fence(__ATOMIC_ACQUIRE, "agent");
    asm volatile("s_waitcnt vmcnt(0)" ::: "memory");
    bf16_t* hres = (bf16_t*)(ws + WS_H);
    norm_pass<false>(P.x, ubuf, P.norm1_g, mod0, 0, &P, hres);
    GSYNC(2);
    { Gemm g{ubuf, (const bf16_t*)(ws + WS_WIN), DM, DM, DM, (NT + NCTX) / 256, PW / 256, 0, 0, 0}; EpiProj E{pbuf, P.q_g, P.k_g}; gemm_phase(lds, g, E); }
    GSYNC(3);
    natten_phase(P, lds);
    dft_stage1(P, lds);
    GSYNC(4);
    dft_stage2(P, lds);
    GSYNC(5);
    { Gemm g{cat, (const bf16_t*)(ws + WS_WOUT), DM, DM, DM, NT / 256, DM / 256, 0, 0, 0}; EpiResT<true, true> E{hres, hres, mod0 + 2048, nullptr}; gemm_phase(lds, g, E); }
    GSYNC(6);
    norm_pass<true>(hres, ubuf, P.norm2_g, mod0, 1, nullptr);
    GSYNC(7);
    { Gemm g{ubuf, (const bf16_t*)(ws + WS_W1), DM, DM, DM, NT / 256, HID / 256, 0, 0, 0}; EpiAct E{abuf, HID}; gemm_phase(lds, g, E); }
    GSYNC(8);
    { Gemm g{abuf, (const bf16_t*)(ws + WS_W2), HID, HID, HID, NT / 256, DM / 256, 0, HID / 64, HID / 64, 1}; EpiResT<true, true> E{hres, hres, mod0 + 5120, nullptr}; gemm_phase(lds, g, E); }
    GSYNC(9);
    pool_norm_fused(hres, P.norm1_g + DM, mod1, pooled, lds);
    GSYNC(11);
    { Gemm g{pooled, (const bf16_t*)(ws + WS_WPOOL), DM, 256, 256, NT / 256, 4, 512, 0, 0}; EpiResT<true, true> E{hres, hres, mod1 + 2048, P.pool_scale}; gemm_phase(lds, g, E); }
    GSYNC(12);
    norm_pass<true>(hres, ubuf, P.norm2_g + DM, mod1, 1, nullptr);
    GSYNC(13);
    { Gemm g{ubuf, (const bf16_t*)(ws + WS_W1) + (size_t)HID * DM, DM, DM, DM, NT / 256, HID / 256, 0, 0, 0}; EpiAct E{abuf, HID}; gemm_phase(lds, g, E); }
    GSYNC(14);
    { Gemm g{abuf, (const bf16_t*)(ws + WS_W2) + (size_t)DM * HID, HID, HID, HID, NT / 256, DM / 256, 0, HID / 64, HID / 64, 1}; EpiResT<true, false> E{hres, P.out, mod1 + 5120, nullptr}; gemm_phase(lds, g, E); }
}

extern "C" void kernel_launch(void* const* d_in, const int* in_sizes, int n_in, void* d_out, int out_size, void* d_ws, size_t ws_size, hipStream_t stream) {
    static int grid_blocks = 0;
    if (grid_blocks == 0) {
        if (n_in != 18 || out_size != NT * DM || ws_size < WS_END) { fprintf(stderr, "kernel_launch: unexpected shapes (n_in %d out %d ws %zu need %zu)\n", n_in, out_size, ws_size, (size_t)WS_END); grid_blocks = -1; return; }
        int dev = 0, cus = 0, per_cu = 0;
        (void)hipGetDevice(&dev);
        (void)hipDeviceGetAttribute(&cus, hipDeviceAttributeMultiprocessorCount, dev);
        if (hipFuncSetAttribute((const void*)fwd_megakernel, hipFuncAttributeMaxDynamicSharedMemorySize, LDS_BYTES) != hipSuccess) { fprintf(stderr, "kernel_launch: hipFuncSetAttribute failed\n"); grid_blocks = -1; return; }
        if (hipOccupancyMaxActiveBlocksPerMultiprocessor(&per_cu, (const void*)fwd_megakernel, 512, LDS_BYTES) != hipSuccess || per_cu < 1) { fprintf(stderr, "kernel_launch: occupancy query failed (%d)\n", per_cu); (void)hipGetLastError(); per_cu = 1; }
        grid_blocks = cus * 1;
        (void)per_cu;
    }
    if (grid_blocks < 0) return;
    Params p{};
    p.x = (const float*)d_in[0]; p.c = (const float*)d_in[1]; p.ctx = (const float*)d_in[2]; p.c_ctx = (const float*)d_in[3]; p.w_mod = (const float*)d_in[4]; p.b_mod = (const float*)d_in[5];
    p.norm1_g = (const float*)d_in[6]; p.norm2_g = (const float*)d_in[7]; p.w_in = (const float*)d_in[8]; p.w_four = (const float*)d_in[9]; p.q_g = (const float*)d_in[10]; p.k_g = (const float*)d_in[11];
    p.rpb = (const float*)d_in[12]; p.w_out = (const float*)d_in[13]; p.w_pool = (const float*)d_in[14]; p.pool_scale = (const float*)d_in[15]; p.w_mlp1 = (const float*)d_in[16]; p.w_mlp2 = (const float*)d_in[17];
    p.out = (float*)d_out; p.ws = (unsigned char*)d_ws;
    if (hipMemsetAsync((char*)d_ws + WS_CTL, 0, 16384, stream) != hipSuccess) { fprintf(stderr, "kernel_launch: memset failed\n"); return; }
    void* args[] = {&p};
    hipError_t e = hipLaunchCooperativeKernel((const void*)fwd_megakernel, dim3(grid_blocks), dim3(512), args, LDS_BYTES, stream);
    if (e != hipSuccess) fprintf(stderr, "kernel_launch: cooperative launch failed: %s (grid %d)\n", hipGetErrorString(e), grid_blocks);
}
```

```cpp
#include <hip/hip_runtime.h>
#include <hip/hip_cooperative_groups.h>
#include <cstdio>
namespace cg = cooperative_groups;

#define LAS __attribute__((address_space(3)))
typedef unsigned short bf16_t;
typedef short bf16x8 __attribute__((ext_vector_type(8)));
typedef short s16x4 __attribute__((ext_vector_type(4)));
typedef float f32x4 __attribute__((ext_vector_type(4)));
typedef unsigned u32x4 __attribute__((ext_vector_type(4)));
typedef unsigned u32x2 __attribute__((ext_vector_type(2)));

constexpr int DM = 1024, NB = 4, SEQ = 8192, NT = NB * SEQ, CTXL = 256, NCTX = NB * CTXL, HID = 4096, NMOD = 6 * DM;
constexpr int PW = 2048;
constexpr int LDS_BYTES = 139264;

constexpr size_t al256(size_t x) { return (x + 255) & ~(size_t)255; }
constexpr size_t WS_CTL = 0;
constexpr size_t WS_MOD0 = 16384;
constexpr size_t WS_MOD1 = WS_MOD0 + al256((size_t)NB * NMOD * 4);
constexpr size_t WS_MODC = WS_MOD1 + al256((size_t)NB * NMOD * 4);
constexpr size_t WS_WIN = WS_MODC + al256(2048 * 4);
constexpr size_t WS_WOUT = WS_WIN + (size_t)PW * DM * 2;
constexpr size_t WS_W1 = WS_WOUT + (size_t)DM * DM * 2;
constexpr size_t WS_W2 = WS_W1 + (size_t)2 * HID * DM * 2;
constexpr size_t WS_WPOOL = WS_W2 + (size_t)2 * HID * DM * 2;
constexpr size_t WS_D1C = WS_WPOOL + (size_t)DM * 256 * 2;
constexpr size_t WS_D1S = WS_D1C + 128 * 128 * 2;
constexpr size_t WS_D2 = WS_D1S + 128 * 128 * 2;
constexpr size_t WS_U = WS_D2 + 64 * 128 * 2;
constexpr size_t WS_BIG = WS_U + (size_t)(NT + NCTX) * DM * 2;
constexpr size_t BIG_P = 0;
constexpr size_t BIG_S1 = BIG_P + (size_t)(NT + NCTX) * PW * 2;
constexpr size_t BIG_CAT = BIG_S1 + (size_t)NT * 1024 * 2;
constexpr size_t BIG_END = BIG_CAT + (size_t)NT * 1024 * 2;
constexpr size_t BIG_A = 0;
constexpr size_t BIG_POOL = 0;
constexpr size_t BIG_SIZE = BIG_END > (size_t)NT * HID * 2 ? BIG_END : (size_t)NT * HID * 2;
constexpr size_t WS_H = WS_BIG + BIG_SIZE;
constexpr size_t WS_END = WS_H + (size_t)NT * DM * 2;

struct Params {
    const float *x, *c, *ctx, *c_ctx, *w_mod, *b_mod, *norm1_g, *norm2_g, *w_in, *w_four, *q_g, *k_g, *rpb, *w_out, *w_pool, *pool_scale, *w_mlp1, *w_mlp2;
    float* out; unsigned char* ws;
};

typedef float f32x2 __attribute__((ext_vector_type(2)));
typedef __bf16 bf16x2v __attribute__((ext_vector_type(2)));
__device__ __forceinline__ unsigned cvt_pk_bf16(float lo, float hi) { const f32x2 f = {lo, hi}; const bf16x2v b = __builtin_convertvector(f, bf16x2v); return __builtin_bit_cast(unsigned, b); }
__device__ __forceinline__ float bf_lo(unsigned u) { return __uint_as_float(u << 16); }
__device__ __forceinline__ float bf_hi(unsigned u) { return __uint_as_float(u & 0xffff0000u); }
template <bool BF> __device__ __forceinline__ f32x4 ld4(const void* base, size_t idx) {
    if (BF) { const u32x2 v = *(const u32x2*)((const bf16_t*)base + idx); return (f32x4){bf_lo(v.x), bf_hi(v.x), bf_lo(v.y), bf_hi(v.y)}; }
    else return *(const f32x4*)((const float*)base + idx);
}
template <bool BF> __device__ __forceinline__ void st4(void* base, size_t idx, const f32x4 v) {
    if (BF) *(u32x2*)((bf16_t*)base + idx) = (u32x2){cvt_pk_bf16(v[0], v[1]), cvt_pk_bf16(v[2], v[3])};
    else *(f32x4*)((float*)base + idx) = v;
}
template <bool BF> __device__ __forceinline__ void ld8(const void* base, size_t idx, f32x4& a, f32x4& b) {
    if (BF) { const u32x4 v = *(const u32x4*)((const bf16_t*)base + idx); a = (f32x4){bf_lo(v.x), bf_hi(v.x), bf_lo(v.y), bf_hi(v.y)}; b = (f32x4){bf_lo(v.z), bf_hi(v.z), bf_lo(v.w), bf_hi(v.w)}; }
    else { a = __builtin_nontemporal_load((const f32x4*)((const float*)base + idx)); b = __builtin_nontemporal_load((const f32x4*)((const float*)base + idx + 4)); }
}
template <bool BF> __device__ __forceinline__ void st8(void* base, size_t idx, const f32x4 a, const f32x4 b) {
    if (BF) { u32x4 w; w.x = cvt_pk_bf16(a[0], a[1]); w.y = cvt_pk_bf16(a[2], a[3]); w.z = cvt_pk_bf16(b[0], b[1]); w.w = cvt_pk_bf16(b[2], b[3]); *(u32x4*)((bf16_t*)base + idx) = w; }
    else { __builtin_nontemporal_store(a, (f32x4*)((float*)base + idx)); __builtin_nontemporal_store(b, (f32x4*)((float*)base + idx + 4)); }
}
__device__ __forceinline__ int phys_row(int n, int mode) {
    const int L = n & 255, wc = L >> 6, bj = (L >> 5) & 1, j = L & 3;
    const int fq = mode ? ((L >> 2) & 3) : ((L >> 3) & 3), nn = mode ? ((L >> 4) & 1) : ((L >> 2) & 1);
    return (n & ~255) + 128 * bj + 32 * wc + 16 * nn + 4 * fq + j;
}

constexpr int BM = 256, BK = 64, HALF = 128, HTB = HALF * BK * 2, NXCD = 8, WGM = 4;
__device__ __forceinline__ int lds_byte(int r, int c) { const int st = (r >> 4) * 2 + (c >> 5), rr = r & 15, cc = c & 31, ob = rr * 64 + cc * 2; return st * 1024 + (ob ^ (((ob >> 9) & 1) << 5)); }
__device__ __forceinline__ void stage_rc(int b, int& R, int& C) { const int st = b / 1024, sb = b % 1024, swz = sb ^ (((sb >> 9) & 1) << 5); R = (st >> 1) * 16 + swz / 64; C = (st & 1) * 32 + (swz % 64) / 2; }
struct Unit { int pm, pn; };
struct Gemm { const bf16_t* A; const bf16_t* Bt; int lda, ldb, K, nM, nN, a_pn_bytes, a_blk, b_blk; int a_nt = 0; };
__device__ __forceinline__ size_t blk_off(int row, int col, int nkt) { return ((size_t)(row >> 7) * nkt + (col >> 6)) * 16384 + lds_byte(row & 127, col & 63); }
struct StaticOrder {
    int nM, nN, nwg, G, c;
    __device__ void init(int nM_, int nN_, int G_, int c_) { nM = nM_; nN = nN_; nwg = nM * nN; G = G_; c = c_; }
    __device__ bool next(int i, Unit& u) const {
        const long L = (long)i * G + c; if (L >= nwg) return false;
        int wgid = (int)L; { const int q = nwg / NXCD, r = nwg % NXCD, xcd = wgid % NXCD, off = wgid / NXCD; wgid = (xcd < r ? xcd * (q + 1) : r * (q + 1) + (xcd - r) * q) + off; }
        const int nig = WGM * nN, gid = wgid / nig, fm = gid * WGM, gsz = (nM - fm) < WGM ? (nM - fm) : WGM;
        u.pm = fm + ((wgid % nig) % gsz); u.pn = (wgid % nig) / gsz; return true;
    }
};

template <class Epi>
__device__ __forceinline__ void gemm_phase(LAS unsigned char* lds, const Gemm g, const Epi& E) {
    const int tid = threadIdx.x, wid = __builtin_amdgcn_readfirstlane(tid >> 6), lane = tid & 63, wr = wid >> 2, wc = wid & 3, fr = lane & 15, fq = lane >> 4;
    const int K = g.K, nt = K / BK;
    StaticOrder S; S.init(g.nM, g.nN, (int)gridDim.x, (int)blockIdx.x);
    unsigned voffA[2], voffB[2];
#pragma unroll
    for (int i = 0; i < 2; ++i) { int R, C; stage_rc(tid * 16 + i * 8192, R, C); voffA[i] = g.a_blk ? (unsigned)(tid * 16 + i * 8192) : (unsigned)(R * g.lda + C) * 2u; voffB[i] = g.b_blk ? (unsigned)(tid * 16 + i * 8192) : (unsigned)(R * g.ldb + C) * 2u; }
    const size_t kstepA = g.a_blk ? (size_t)16384 : (size_t)(BK * 2), kstepB = g.b_blk ? (size_t)16384 : (size_t)(BK * 2);
    const size_t hstepA = g.a_blk ? (size_t)g.a_blk * 16384 : (size_t)HALF * g.lda * 2, hstepB = g.b_blk ? (size_t)g.b_blk * 16384 : (size_t)HALF * g.ldb * 2;
    const size_t tstepA = 2 * hstepA, tstepB = 2 * hstepB;
    const unsigned ldsw = (unsigned)wid * 1024u;
    const int aoff = lds_byte(wr * 64 + fr, fq * 8), boff = lds_byte(wc * 32 + fr, fq * 8);
#define G_SA(b, h) (((b) * 2 + (h)) * HTB)
#define G_SB(b, h) ((4 + (b) * 2 + (h)) * HTB)
#define G_STAGE_A(bufoff, gbase, voff) do { if (g.a_nt) { _Pragma("unroll") for (int _i = 0; _i < 2; ++_i) \
        __builtin_amdgcn_global_load_lds((const unsigned*)((const char*)(gbase) + (voff)[_i]), (LAS unsigned*)(lds + (bufoff) + ldsw + _i * 8192), 16, 0, 2); } else { _Pragma("unroll") for (int _i = 0; _i < 2; ++_i) \
        __builtin_amdgcn_global_load_lds((const unsigned*)((const char*)(gbase) + (voff)[_i]), (LAS unsigned*)(lds + (bufoff) + ldsw + _i * 8192), 16, 0, 0); } } while (0)
#define G_STAGE(bufoff, gbase, voff) do { _Pragma("unroll") for (int _i = 0; _i < 2; ++_i) \
        __builtin_amdgcn_global_load_lds((const unsigned*)((const char*)(gbase) + (voff)[_i]), (LAS unsigned*)(lds + (bufoff) + ldsw + _i * 8192), 16, 0, 0); } while (0)
#define G_LDA(dst, b, h) do { _Pragma("unroll") for (int m = 0; m < 4; ++m) _Pragma("unroll") for (int k = 0; k < 2; ++k) dst[m][k] = *(const LAS bf16x8*)(lds + G_SA(b, h) + aoff + m * 2048 + k * 1024); } while (0)
#define G_LDB(dst, b, h) do { _Pragma("unroll") for (int n = 0; n < 2; ++n) _Pragma("unroll") for (int k = 0; k < 2; ++k) dst[n][k] = *(const LAS bf16x8*)(lds + G_SB(b, h) + boff + n * 2048 + k * 1024); } while (0)
#define G_MMA(ai, bj, At, Bt) do { __builtin_amdgcn_s_setprio(1); _Pragma("unroll") for (int m = 0; m < 4; ++m) _Pragma("unroll") for (int n = 0; n < 2; ++n) _Pragma("unroll") for (int k = 0; k < 2; ++k) \
        acc[ai][bj][m][n] = __builtin_amdgcn_mfma_f32_16x16x32_bf16(Bt[n][k], At[m][k], acc[ai][bj][m][n], 0, 0, 0); __builtin_amdgcn_s_setprio(0); } while (0)
#define G_WAIT_V(n) asm volatile("s_waitcnt vmcnt(" #n ")" ::: "memory")
#define G_WAIT_L(n) asm volatile("s_waitcnt lgkmcnt(" #n ")" ::: "memory")
#define G_BAR __builtin_amdgcn_s_barrier()
#define G_SCHED __builtin_amdgcn_sched_barrier(0)
    Unit cur, nxt; int ui = 0;
    if (!S.next(0, cur)) return;
    f32x4 acc[2][2][4][2];
#pragma unroll
    for (int a = 0; a < 2; ++a)
#pragma unroll
        for (int b = 0; b < 2; ++b)
#pragma unroll
            for (int m = 0; m < 4; ++m)
#pragma unroll
                for (int n = 0; n < 2; ++n) acc[a][b][m][n] = (f32x4){0.f, 0.f, 0.f, 0.f};
    bf16x8 At[4][2], B0[2][2], B1[2][2];
    const char* cA = (const char*)g.A + (size_t)cur.pm * tstepA + (size_t)cur.pn * g.a_pn_bytes; const char* cB = (const char*)g.Bt + (size_t)cur.pn * tstepB;
    G_STAGE(G_SB(0, 0), cB, voffB); G_STAGE_A(G_SA(0, 0), cA, voffA); G_STAGE(G_SB(0, 1), cB + hstepB, voffB); G_STAGE_A(G_SA(0, 1), cA + hstepA, voffA);
    if (wr == 1) G_BAR;
    G_WAIT_V(4); G_BAR;
    G_STAGE(G_SB(1, 0), cB + kstepB, voffB); G_STAGE_A(G_SA(1, 0), cA + kstepA, voffA); G_STAGE(G_SB(1, 1), cB + hstepB + kstepB, voffB);
    G_WAIT_V(6); G_BAR;
    for (;;) {
        const bool has_next = S.next(ui + 1, nxt);
        const char* nA = has_next ? (const char*)g.A + (size_t)nxt.pm * tstepA + (size_t)nxt.pn * g.a_pn_bytes : cA; const char* nB = has_next ? (const char*)g.Bt + (size_t)nxt.pn * tstepB : cB;
        for (int t = 0; t < nt; t += 2) {
            const bool last = (t == nt - 2);
            const char* a1 = cA + (size_t)(t + 1) * kstepA;
            const char* a2 = last ? nA : cA + (size_t)(t + 2) * kstepA; const char* b2 = last ? nB : cB + (size_t)(t + 2) * kstepB;
            const char* a3 = a2 + kstepA; const char* b3 = b2 + kstepB;
            G_LDB(B0, 0, 0); G_SCHED; G_LDA(At, 0, 0); G_STAGE_A(G_SA(1, 1), a1 + hstepA, voffA);
            G_WAIT_L(8); G_BAR; G_WAIT_L(0); G_MMA(0, 0, At, B0); G_BAR; G_SCHED;
            G_LDB(B1, 0, 1); G_STAGE(G_SB(0, 0), b2, voffB);
            G_BAR; G_WAIT_L(0); G_MMA(0, 1, At, B1); G_BAR;
            G_LDA(At, 0, 1); G_STAGE_A(G_SA(0, 0), a2, voffA);
            G_BAR; G_WAIT_L(0); G_MMA(1, 0, At, B0); G_BAR; G_SCHED;
            G_STAGE(G_SB(0, 1), b2 + hstepB, voffB);
            G_WAIT_V(6); G_BAR; G_MMA(1, 1, At, B1); G_BAR;
            G_LDB(B0, 1, 0); G_SCHED; G_LDA(At, 1, 0); G_STAGE_A(G_SA(0, 1), a2 + hstepA, voffA);
            G_WAIT_L(8); G_BAR; G_WAIT_L(0); G_MMA(0, 0, At, B0); G_BAR; G_SCHED;
            G_LDB(B1, 1, 1); G_STAGE(G_SB(1, 0), b3, voffB);
            G_BAR; G_WAIT_L(0); G_MMA(0, 1, At, B1); G_BAR;
            G_LDA(At, 1, 1); G_STAGE_A(G_SA(1, 0), a3, voffA);
            G_BAR; G_WAIT_L(0); G_MMA(1, 0, At, B0); G_BAR; G_SCHED;
            G_STAGE(G_SB(1, 1), b3 + hstepB, voffB);
            G_WAIT_V(6); G_BAR; G_MMA(1, 1, At, B1); G_BAR;
        }
        E(acc, cur, wr, wc, fr, fq);
        if (!has_next) break;
#pragma unroll
        for (int a = 0; a < 2; ++a)
#pragma unroll
            for (int b = 0; b < 2; ++b)
#pragma unroll
                for (int m = 0; m < 4; ++m)
#pragma unroll
                    for (int n = 0; n < 2; ++n) acc[a][b][m][n] = (f32x4){0.f, 0.f, 0.f, 0.f};
        cur = nxt; cA = nA; cB = nB; ++ui;
    }
    G_WAIT_V(0);
    if (wr == 0) G_BAR;
    G_BAR;
#undef G_SA
#undef G_SB
#undef G_STAGE
#undef G_STAGE_A
#undef G_LDA
#undef G_LDB
#undef G_MMA
#undef G_WAIT_V
#undef G_WAIT_L
#undef G_BAR
#undef G_SCHED
}

__device__ __forceinline__ void store16_bf16(bf16_t* dst, const float (&v)[16]) {
    u32x4 w0, w1;
    w0.x = cvt_pk_bf16(v[0], v[1]); w0.y = cvt_pk_bf16(v[2], v[3]); w0.z = cvt_pk_bf16(v[4], v[5]); w0.w = cvt_pk_bf16(v[6], v[7]);
    w1.x = cvt_pk_bf16(v[8], v[9]); w1.y = cvt_pk_bf16(v[10], v[11]); w1.z = cvt_pk_bf16(v[12], v[13]); w1.w = cvt_pk_bf16(v[14], v[15]);
    *(u32x4*)dst = w0; *(u32x4*)(dst + 8) = w1;
}
__device__ __forceinline__ void store8_bf16(bf16_t* dst, const f32x4 a, const f32x4 b) {
    u32x4 w; w.x = cvt_pk_bf16(a[0], a[1]); w.y = cvt_pk_bf16(a[2], a[3]); w.z = cvt_pk_bf16(b[0], b[1]); w.w = cvt_pk_bf16(b[2], b[3]);
    *(u32x4*)dst = w;
}
__device__ __forceinline__ void store8_bf16_nt(bf16_t* dst, const f32x4 a, const f32x4 b) {
    u32x4 w; w.x = cvt_pk_bf16(a[0], a[1]); w.y = cvt_pk_bf16(a[2], a[3]); w.z = cvt_pk_bf16(b[0], b[1]); w.w = cvt_pk_bf16(b[2], b[3]);
    __builtin_nontemporal_store(w, (u32x4*)dst);
}
struct EpiProj {
    bf16_t* P; const float* qg; const float* kg;
    __device__ __forceinline__ void operator()(const f32x4 (&acc)[2][2][4][2], const Unit& u, int wr, int wc, int fr, int fq) const {
        const int row0 = u.pm * BM + wr * 64 + fr, col0 = u.pn * BM + wc * 64 + fq * 8;
        const bool hn = (u.pn >= 2 && u.pn < 6);
        const float qs = (u.pn < 4) ? 0.18033688011112042f : 1.0f;
        f32x4 gv[2][2];
        if (hn) { const float* gp = (u.pn < 4 ? qg : kg) + fq * 8;
#pragma unroll
            for (int bj = 0; bj < 2; ++bj)
#pragma unroll
                for (int n = 0; n < 2; ++n) gv[bj][n] = *(const f32x4*)(gp + 32 * bj + 4 * n); }
#pragma unroll
        for (int ai = 0; ai < 2; ++ai)
#pragma unroll
            for (int m = 0; m < 4; ++m) {
                f32x4 v[2][2];
#pragma unroll
                for (int bj = 0; bj < 2; ++bj)
#pragma unroll
                    for (int n = 0; n < 2; ++n) v[bj][n] = acc[ai][bj][m][n];
                if (hn) {
                    float ss = 0.f;
#pragma unroll
                    for (int bj = 0; bj < 2; ++bj)
#pragma unroll
                        for (int n = 0; n < 2; ++n) ss += v[bj][n][0] * v[bj][n][0] + v[bj][n][1] * v[bj][n][1] + v[bj][n][2] * v[bj][n][2] + v[bj][n][3] * v[bj][n][3];
                    ss += __shfl_xor(ss, 16); ss += __shfl_xor(ss, 32);
                    const float rs = rsqrtf(ss * (1.0f / 64.0f) + 1e-6f);
#pragma unroll
                    for (int bj = 0; bj < 2; ++bj)
#pragma unroll
                        for (int n = 0; n < 2; ++n) v[bj][n] = v[bj][n] * (rs * qs) * gv[bj][n];
                }
                bf16_t* dst = P + (size_t)(row0 + ai * HALF + m * 16) * PW + col0;
                store8_bf16(dst, v[0][0], v[0][1]); store8_bf16(dst + 32, v[1][0], v[1][1]);
            }
    }
};
struct EpiAct {
    bf16_t* O; int ldo;
    __device__ __forceinline__ void operator()(const f32x4 (&acc)[2][2][4][2], const Unit& u, int wr, int wc, int fr, int fq) const {
        const int row0 = u.pm * BM + wr * 64 + fr, col0 = u.pn * BM + wc * 64 + fq * 8;
#pragma unroll
        for (int ai = 0; ai < 2; ++ai)
#pragma unroll
            for (int m = 0; m < 4; ++m) {
                const int row = row0 + ai * HALF + m * 16;
#pragma unroll
                for (int bj = 0; bj < 2; ++bj) { f32x4 a = acc[ai][bj][m][0], b = acc[ai][bj][m][1];
                    bf16_t* dst = (bf16_t*)((char*)O + blk_off(row, col0 + 32 * bj, ldo / 64));
#pragma unroll
                    for (int j = 0; j < 4; ++j) { const float ra = fmaxf(a[j], 0.f), rb = fmaxf(b[j], 0.f); a[j] = ra * ra; b[j] = rb * rb; }
                    store8_bf16_nt(dst, a, b); }
            }
    }
};
template <bool RB, bool OB> struct EpiResT {
    const void* res; void* out; const float* gate; const float* cscale;
    __device__ __forceinline__ void operator()(const f32x4 (&acc)[2][2][4][2], const Unit& u, int wr, int wc, int fr, int fq) const {
        const int row0 = u.pm * BM + wr * 64 + fr, col0 = u.pn * BM + wc * 64 + fq * 8;
        const int b = u.pm >> 5;
        f32x4 gv[2][2];
#pragma unroll
        for (int bj = 0; bj < 2; ++bj)
#pragma unroll
            for (int n = 0; n < 2; ++n) { f32x4 t = *(const f32x4*)(gate + (size_t)b * NMOD + col0 + 32 * bj + 4 * n);
                if (cscale) { const f32x4 s = *(const f32x4*)(cscale + col0 + 32 * bj + 4 * n); t = t * s; }
                gv[bj][n] = t; }
#pragma unroll
        for (int ai = 0; ai < 2; ++ai)
#pragma unroll
            for (int m = 0; m < 4; ++m) {
                const size_t off = (size_t)(row0 + ai * HALF + m * 16) * DM + col0;
#pragma unroll
                for (int bj = 0; bj < 2; ++bj) { f32x4 r0, r1; ld8<RB>(res, off + 32 * bj, r0, r1);
                    st8<OB>(out, off + 32 * bj, r0 + gv[bj][0] * acc[ai][bj][m][0], r1 + gv[bj][1] * acc[ai][bj][m][1]); }
            }
    }
};

__device__ void mod_task(const Params& P, int t, LAS float* sl) {
    const int tid = threadIdx.x, l = t / 96, n0 = (t % 96) * 64;
#pragma unroll
    for (int i = tid; i < 5 * 1024; i += 512) { const float v = (i < 4096) ? P.c[i] : P.c_ctx[i - 4096]; sl[i] = v / (1.0f + expf(-v)); }
    __syncthreads();
    const int kg = tid >> 6, ln = tid & 63;
    const float* w = P.w_mod + (size_t)l * DM * NMOD + n0 + ln;
    float a0 = 0.f, a1 = 0.f, a2 = 0.f, a3 = 0.f, a4 = 0.f;
#pragma unroll 8
    for (int k = kg * 128; k < kg * 128 + 128; ++k) { const float wv = __builtin_nontemporal_load(w + (size_t)k * NMOD); a0 += sl[k] * wv; a1 += sl[1024 + k] * wv; a2 += sl[2048 + k] * wv; a3 += sl[3072 + k] * wv; a4 += sl[4096 + k] * wv; }
    LAS float* red = sl + 5 * 1024;
    red[(kg * 5 + 0) * 64 + ln] = a0; red[(kg * 5 + 1) * 64 + ln] = a1; red[(kg * 5 + 2) * 64 + ln] = a2; red[(kg * 5 + 3) * 64 + ln] = a3; red[(kg * 5 + 4) * 64 + ln] = a4;
    __syncthreads();
    if (tid < 320) { const int r = tid >> 6, n = tid & 63; float s = 0.f;
        for (int g = 0; g < 8; ++g) s += red[(g * 5 + r) * 64 + n];
        s += P.b_mod[l * NMOD + n0 + n];
        float* modl = (float*)(P.ws + (l ? WS_MOD1 : WS_MOD0));
        if (r < 4) modl[r * NMOD + n0 + n] = s; else if (l == 0 && n0 + n < 2048) ((float*)(P.ws + WS_MODC))[n0 + n] = s; }
    __syncthreads();
}
__device__ void fold_win_task(const Params& P, int t, LAS float* sl) {
    const int tid = threadIdx.x, g = t >> 4, k0 = (t & 15) * 64;
    LAS float* wt = sl;
    LAS float* ctab = sl + 64 * 132;
    { const int r = tid >> 5, c4 = tid & 31;
#pragma unroll
        for (int i = 0; i < 4; ++i) { const f32x4 v = *(const f32x4*)(P.w_in + (size_t)(k0 + r + 16 * i) * PW + g * 128 + c4 * 4); LAS float* d = wt + (r + 16 * i) * 132 + c4 * 4; d[0] = v[0]; d[1] = v[1]; d[2] = v[2]; d[3] = v[3]; } }
    if (tid < 128) ctab[tid] = cospif((float)tid * (1.0f / 64.0f));
    __syncthreads();
    const int jj = tid & 127, kq = tid >> 7;
    float acc[16];
#pragma unroll
    for (int i = 0; i < 16; ++i) acc[i] = 0.f;
    const int mul = (jj <= 64) ? jj : (jj - 64), sub = (jj <= 64) ? 0 : 32;
    for (int c = 0; c < 128; c += 4) {
        const float d0 = ctab[(mul * c - sub) & 127], d1 = ctab[(mul * (c + 1) - sub) & 127], d2 = ctab[(mul * (c + 2) - sub) & 127], d3 = ctab[(mul * (c + 3) - sub) & 127];
#pragma unroll
        for (int i = 0; i < 16; ++i) { const f32x4 w = *(const LAS f32x4*)(wt + (kq * 16 + i) * 132 + c); acc[i] += w[0] * d0 + w[1] * d1 + w[2] * d2 + w[3] * d3; }
    }
    bf16_t* dst = (bf16_t*)(P.ws + WS_WIN) + (size_t)phys_row(g * 128 + jj, 0) * DM + k0 + kq * 16;
    store16_bf16(dst, acc);
    __syncthreads();
}
__device__ void fold_wout_task(const Params& P, int t, LAS float* sl) {
    const int tid = threadIdx.x, g = t >> 4, d0 = (t & 15) * 64;
    LAS float* wfp = sl;
    LAS float* wo = sl + 128 * 128;
    const float* base = P.w_four + (size_t)g * 128 * 128;
#pragma unroll 8
    for (int idx = tid; idx < 128 * 128; idx += 512) { const int jj = idx >> 7, e = idx & 127; float v;
        if (jj == 0 || jj == 64) v = base[jj * 128 + e];
        else if (jj < 64) v = base[jj * 128 + e] + base[(128 - jj) * 128 + e];
        else { const int l = jj - 64; v = base[(128 - l) * 128 + e] - base[l * 128 + e]; }
        wfp[idx] = v; }
    { const int r = tid >> 4, c4 = tid & 15;
#pragma unroll
        for (int i = 0; i < 4; ++i) { const f32x4 v = *(const f32x4*)(P.w_out + (size_t)(g * 128 + r + 32 * i) * DM + d0 + c4 * 4); LAS float* d = wo + (r + 32 * i) * 64 + c4 * 4; d[0] = v[0]; d[1] = v[1]; d[2] = v[2]; d[3] = v[3]; } }
    __syncthreads();
    const int dd = tid & 63, jq = tid >> 6;
    float acc[16];
#pragma unroll
    for (int i = 0; i < 16; ++i) acc[i] = 0.f;
    for (int e = 0; e < 128; e += 4) {
        const float w0 = wo[e * 64 + dd], w1 = wo[(e + 1) * 64 + dd], w2 = wo[(e + 2) * 64 + dd], w3 = wo[(e + 3) * 64 + dd];
#pragma unroll
        for (int i = 0; i < 16; ++i) { const f32x4 f = *(const LAS f32x4*)(wfp + (jq * 16 + i) * 128 + e); acc[i] += f[0] * w0 + f[1] * w1 + f[2] * w2 + f[3] * w3; }
    }
    bf16_t* dst = (bf16_t*)(P.ws + WS_WOUT) + (size_t)phys_row(d0 + dd, 0) * DM + g * 128 + jq * 16;
    store16_bf16(dst, acc);
    __syncthreads();
}
__device__ void conv_tile(const float* src, int ld, int k0, int n0, bf16_t* dst, int ldd, int kdst0, int ndst0, int mode, LAS float* sl, int blocked = 0) {
    const int tid = threadIdx.x;
    { const int r = tid >> 4, c4 = tid & 15;
        f32x4 v[4][2];
#pragma unroll
        for (int t = 0; t < 4; ++t)
#pragma unroll
            for (int i = 0; i < 2; ++i) v[t][i] = __builtin_nontemporal_load((const f32x4*)(src + (size_t)(k0 + r + 32 * i) * ld + n0 + t * 64 + c4 * 4));
#pragma unroll
        for (int t = 0; t < 4; ++t)
#pragma unroll
            for (int i = 0; i < 2; ++i) { LAS float* d = sl + t * (64 * 65) + (r + 32 * i) * 65 + c4 * 4; d[0] = v[t][i][0]; d[1] = v[t][i][1]; d[2] = v[t][i][2]; d[3] = v[t][i][3]; } }
    __syncthreads();
    { const int nn = tid >> 3, kc = tid & 7;
#pragma unroll
        for (int t = 0; t < 4; ++t) { float v[8];
#pragma unroll
            for (int i = 0; i < 8; ++i) v[i] = sl[t * (64 * 65) + (kc * 8 + i) * 65 + nn];
            u32x4 w; w.x = cvt_pk_bf16(v[0], v[1]); w.y = cvt_pk_bf16(v[2], v[3]); w.z = cvt_pk_bf16(v[4], v[5]); w.w = cvt_pk_bf16(v[6], v[7]);
            const int prow = phys_row(ndst0 + n0 + t * 64 + nn, mode), pcol = kdst0 + k0 + kc * 8;
            if (blocked) *(u32x4*)((char*)dst + blk_off(prow, pcol, ldd / 64)) = w; else *(u32x4*)(dst + (size_t)prow * ldd + pcol) = w; } }
    __syncthreads();
}
__device__ void dft_tab_task(const Params& P) {
    bf16_t* d1c = (bf16_t*)(P.ws + WS_D1C); bf16_t* d1s = (bf16_t*)(P.ws + WS_D1S); bf16_t* d2 = (bf16_t*)(P.ws + WS_D2);
    for (int idx = threadIdx.x; idx < 128 * 128; idx += 512) { const int ka = idx >> 7, a = idx & 127; const float ang = (float)((ka * a) & 127) * (1.0f / 64.0f);
        d1c[idx] = (bf16_t)(cvt_pk_bf16(cospif(ang), 0.f) & 0xffff); d1s[idx] = (bf16_t)(cvt_pk_bf16(-sinpif(ang), 0.f) & 0xffff); }
    for (int idx = threadIdx.x; idx < 64 * 128; idx += 512) { const int kb = idx >> 7, kk = idx & 127, bb = kk >> 1; const float ang = (float)((kb * bb) & 63) * (1.0f / 32.0f);
        const float v = ((kk & 1) ? sinpif(ang) : cospif(ang)) * (1.0f / 32.0f);
        d2[idx] = (bf16_t)(cvt_pk_bf16(v, 0.f) & 0xffff); }
}
__device__ void phase0(const Params& P, LAS unsigned char* lds) {
    LAS float* sl = (LAS float*)lds;
    constexpr int T_MOD = 192, T_FWIN = 64, T_FWOUT = 64, T_W1 = 512, T_W2 = 512, T_WIN = 96, T_WOUT = 32, T_POOL = 16, T_DFT = 1;
    constexpr int NTASK = T_MOD + T_FWIN + T_FWOUT + T_W1 + T_W2 + T_WIN + T_WOUT + T_POOL + T_DFT;
    unsigned* qhead = (unsigned*)(P.ws + WS_CTL) + 3600;
    volatile LAS unsigned* qslot = (volatile LAS unsigned*)(lds + LDS_BYTES - 8);
    for (;;) {
        __syncthreads();
        if (threadIdx.x == 0) *qslot = __hip_atomic_fetch_add(qhead, 1u, __ATOMIC_RELAXED, __HIP_MEMORY_SCOPE_AGENT);
        __syncthreads();
        const int t = (int)*qslot;
        if (t >= NTASK) break;
        int q = t;
        if (q < T_MOD) { mod_task(P, q, sl); continue; } q -= T_MOD;
        if (q < T_FWIN) { fold_win_task(P, q, sl); continue; } q -= T_FWIN;
        if (q < T_FWOUT) { fold_wout_task(P, q, sl); continue; } q -= T_FWOUT;
        if (q < T_W1) { const int l = q >> 8, r = q & 255, kt = r >> 4, ntile = r & 15;
            conv_tile(P.w_mlp1 + (size_t)l * DM * HID, HID, kt * 64, ntile * 256, (bf16_t*)(P.ws + WS_W1) + (size_t)l * HID * DM, DM, 0, 0, 0, sl); continue; } q -= T_W1;
        if (q < T_W2) { const int l = q >> 8, r = q & 255, kt = r >> 2, ntile = r & 3;
            conv_tile(P.w_mlp2 + (size_t)l * HID * DM, DM, kt * 64, ntile * 256, (bf16_t*)(P.ws + WS_W2) + (size_t)l * DM * HID, HID, 0, 0, 0, sl, 1); continue; } q -= T_W2;
        if (q < T_WIN) { const int kt = q / 6, ntile = q % 6;
            conv_tile(P.w_in, PW, kt * 64, 512 + ntile * 256, (bf16_t*)(P.ws + WS_WIN), DM, 0, 0, 0, sl); continue; } q -= T_WIN;
        if (q < T_WOUT) { const int kt = q >> 2, ntile = q & 3;
            conv_tile(P.w_out + (size_t)512 * DM, DM, kt * 64, ntile * 256, (bf16_t*)(P.ws + WS_WOUT), DM, 512, 0, 0, sl); continue; } q -= T_WOUT;
        if (q < T_POOL) { const int g = q >> 2, kt = q & 3;
            conv_tile(P.w_pool + (size_t)g * 256 * 256, 256, kt * 64, 0, (bf16_t*)(P.ws + WS_WPOOL), 256, 0, g * 256, 0, sl); continue; } q -= T_POOL;
        dft_tab_task(P);
    }
}

template <int NR, bool SB>
__device__ __forceinline__ void norm_rows(const void* src, size_t srow, bf16_t* dst, const f32x4 (&gs)[4], const f32x4 (&sh)[4], int lane, bf16_t* cpy = nullptr) {
    f32x4 v[NR][4]; float ss[NR];
#pragma unroll
    for (int r = 0; r < NR; ++r)
#pragma unroll
        for (int j = 0; j < 2; ++j) ld8<SB>(src, (srow + r) * DM + j * 512 + lane * 8, v[r][2 * j], v[r][2 * j + 1]);
#pragma unroll
    for (int r = 0; r < NR; ++r) { ss[r] = 0.f;
#pragma unroll
        for (int i = 0; i < 4; ++i) ss[r] += v[r][i][0] * v[r][i][0] + v[r][i][1] * v[r][i][1] + v[r][i][2] * v[r][i][2] + v[r][i][3] * v[r][i][3]; }
#pragma unroll
    for (int o = 32; o >= 1; o >>= 1)
#pragma unroll
        for (int r = 0; r < NR; ++r) ss[r] += __shfl_xor(ss[r], o);
#pragma unroll
    for (int r = 0; r < NR; ++r) { const float rs = rsqrtf(ss[r] * (1.0f / 1024.0f) + 1e-6f);
#pragma unroll
        for (int j = 0; j < 2; ++j) { const f32x4 a = v[r][2 * j] * rs * gs[2 * j] + sh[2 * j], b = v[r][2 * j + 1] * rs * gs[2 * j + 1] + sh[2 * j + 1];
            st8<true>(dst, (size_t)r * DM + j * 512 + lane * 8, a, b);
            if (cpy) st8<true>(cpy, (size_t)r * DM + j * 512 + lane * 8, v[r][2 * j], v[r][2 * j + 1]); } }
}
__device__ __forceinline__ void load_mod_vecs(const float* gn, const float* shift, const float* scale, f32x4 (&gs)[4], f32x4 (&sh)[4], int lane) {
#pragma unroll
    for (int i = 0; i < 4; ++i) { const int c = (i >> 1) * 512 + lane * 8 + (i & 1) * 4; const f32x4 g = *(const f32x4*)(gn + c), s = *(const f32x4*)(scale + c); gs[i] = g * (s + 1.0f); sh[i] = *(const f32x4*)(shift + c); }
}
template <bool SB>
__device__ __forceinline__ void norm_pass(const void* src, bf16_t* dst, const float* gn, const float* mod, int which, const Params* Pctx, bf16_t* cpy = nullptr) {
    int ltid_ = threadIdx.x; asm volatile("" : "+v"(ltid_));
    const int lane = ltid_ & 63, gw = blockIdx.x * 8 + (ltid_ >> 6), nw = gridDim.x * 8;
    f32x4 gs[4], sh[4];
    int curb = -1;
    for (int r = gw * 4; r < NT; r += nw * 4) {
        const int b = r >> 13;
        if (b != curb) { curb = b; load_mod_vecs(gn, mod + (size_t)b * NMOD + which * 3072, mod + (size_t)b * NMOD + which * 3072 + 1024, gs, sh, lane); }
        norm_rows<4, SB>(src, (size_t)r, dst + (size_t)r * DM, gs, sh, lane, cpy ? cpy + (size_t)r * DM : nullptr);
    }
    if (Pctx) {
        const float* modc = (const float*)(Pctx->ws + WS_MODC);
        load_mod_vecs(gn, modc, modc + 1024, gs, sh, lane);
        for (int r = gw; r < NCTX; r += nw) norm_rows<1, false>(Pctx->ctx, (size_t)r, dst + (size_t)(NT + r) * DM, gs, sh, lane);
    }
}

constexpr int ACT_PITCH = 260;
__device__ __forceinline__ void dft_load_tile(const bf16_t* src, size_t row_stride, LAS unsigned char* act) {
    const int tid = threadIdx.x, chunk = tid & 31, r0 = tid >> 5;
#pragma unroll
    for (int i = 0; i < 8; ++i) { const int r = r0 + 16 * i; const u32x4 v = *(const u32x4*)(src + (size_t)r * row_stride + chunk * 8);
        LAS u32x2* d = (LAS u32x2*)(act + r * (ACT_PITCH * 2) + chunk * 16); d[0] = (u32x2){v.x, v.y}; d[1] = (u32x2){v.z, v.w}; }
}
__device__ __forceinline__ bf16x8 dft_gather(const LAS unsigned char* act, int kc, int fq, int ch) {
    const LAS bf16_t* p = (const LAS bf16_t*)act + (kc * 32 + fq * 8) * ACT_PITCH + ch;
    bf16x8 r;
#pragma unroll
    for (int i = 0; i < 8; ++i) r[i] = (short)p[i * ACT_PITCH];
    return r;
}
__device__ void dft_stage1(const Params& P, LAS unsigned char* lds) {
    const int tid = threadIdx.x, wid = tid >> 6, lane = tid & 63, fr = lane & 15, fq = lane >> 4;
    LAS unsigned char* d1c = lds; LAS unsigned char* d1s = lds + 34816; LAS unsigned char* act = lds + 69632;
    __syncthreads();
#pragma unroll
    for (int id = tid; id < 2 * 2048; id += 512) { const int mtx = id >> 11, r = (id >> 4) & 127, ch = id & 15;
        const u32x4 v = *(const u32x4*)(P.ws + (mtx ? WS_D1S : WS_D1C) + r * 256 + ch * 16);
        *(LAS u32x4*)((mtx ? d1s : d1c) + r * 272 + ch * 16) = v; }
    const bf16_t* pbuf = (const bf16_t*)(P.ws + WS_BIG + BIG_P);
    bf16_t* s1 = (bf16_t*)(P.ws + WS_BIG + BIG_S1);
    for (int u = blockIdx.x; u < NB * 64 * 2; u += gridDim.x) {
        const int half = u & 1, bb = (u >> 1) & 63, b = u >> 7;
        __syncthreads();
        dft_load_tile(pbuf + ((size_t)b * SEQ + bb) * PW + half * 256, (size_t)64 * PW, act);
        __syncthreads();
#pragma unroll 1
        for (int cti = 0; cti < 2; ++cti) {
            const int ct = wid * 2 + cti;
            bf16x8 af[4];
#pragma unroll
            for (int kc = 0; kc < 4; ++kc) af[kc] = dft_gather(act, kc, fq, ct * 16 + fr);
            const int chg = half * 256 + ct * 16 + fq * 4;
#pragma unroll 1
            for (int kt = 0; kt < 8; ++kt) {
                f32x4 aR = (f32x4){0.f, 0.f, 0.f, 0.f}, aI = (f32x4){0.f, 0.f, 0.f, 0.f};
#pragma unroll
                for (int kc = 0; kc < 4; ++kc) {
                    const bf16x8 bc = *(const LAS bf16x8*)(d1c + (kt * 16 + fr) * 272 + (kc * 32 + fq * 8) * 2);
                    const bf16x8 bs = *(const LAS bf16x8*)(d1s + (kt * 16 + fr) * 272 + (kc * 32 + fq * 8) * 2);
                    aR = __builtin_amdgcn_mfma_f32_16x16x32_bf16(af[kc], bc, aR, 0, 0, 0);
                    aI = __builtin_amdgcn_mfma_f32_16x16x32_bf16(af[kc], bs, aI, 0, 0, 0);
                }
                const int ka = kt * 16 + fr;
                float sph, cph; sincospif((float)((ka * bb) & 8191) * (1.0f / 4096.0f), &sph, &cph);
                cph *= (1.0f / 32.0f); sph *= (1.0f / 32.0f);
                float re[4], im[4];
#pragma unroll
                for (int j = 0; j < 4; ++j) { const float x = aR[j], y = aI[j]; const float r0 = x * cph + y * sph, i0 = y * cph - x * sph;
                    const bool isq = ((chg + j) & 127) > 64; re[j] = isq ? -i0 : r0; im[j] = isq ? r0 : i0; }
                bf16_t* d = s1 + ((((size_t)b * 128 + ka) * 64 + bb) * 2) * 512 + chg;
                *(u32x2*)d = (u32x2){cvt_pk_bf16(re[0], re[1]), cvt_pk_bf16(re[2], re[3])};
                *(u32x2*)(d + 512) = (u32x2){cvt_pk_bf16(im[0], im[1]), cvt_pk_bf16(im[2], im[3])};
            }
        }
    }
    __syncthreads();
}
__device__ void dft_stage2(const Params& P, LAS unsigned char* lds) {
    const int tid = threadIdx.x, wid = tid >> 6, lane = tid & 63, fr = lane & 15, fq = lane >> 4;
    LAS unsigned char* d2 = lds; LAS unsigned char* act = lds + 17408;
    __syncthreads();
#pragma unroll
    for (int id = tid; id < 1024; id += 512) { const int r = id >> 4, ch = id & 15; *(LAS u32x4*)(d2 + r * 272 + ch * 16) = *(const u32x4*)(P.ws + WS_D2 + r * 256 + ch * 16); }
    const bf16_t* s1 = (const bf16_t*)(P.ws + WS_BIG + BIG_S1);
    bf16_t* cat = (bf16_t*)(P.ws + WS_BIG + BIG_CAT);
    for (int u = blockIdx.x; u < NB * 128 * 2; u += gridDim.x) {
        const int half = u & 1, ka = (u >> 1) & 127, b = u >> 8;
        __syncthreads();
        dft_load_tile(s1 + (((size_t)b * 128 + ka) * 128) * 512 + half * 256, 512, act);
        __syncthreads();
#pragma unroll 1
        for (int cti = 0; cti < 2; ++cti) {
            const int ct = wid * 2 + cti;
            bf16x8 af[4];
#pragma unroll
            for (int kc = 0; kc < 4; ++kc) af[kc] = dft_gather(act, kc, fq, ct * 16 + fr);
            f32x4 acc[4];
#pragma unroll
            for (int kt = 0; kt < 4; ++kt) acc[kt] = (f32x4){0.f, 0.f, 0.f, 0.f};
#pragma unroll
            for (int kt = 0; kt < 4; ++kt)
#pragma unroll
                for (int kc = 0; kc < 4; ++kc) {
                    const bf16x8 bv = *(const LAS bf16x8*)(d2 + (kt * 16 + fr) * 272 + (kc * 32 + fq * 8) * 2);
                    acc[kt] = __builtin_amdgcn_mfma_f32_16x16x32_bf16(af[kc], bv, acc[kt], 0, 0, 0);
                }
#pragma unroll
            for (int kt = 0; kt < 4; ++kt) { const int kb = kt * 16 + fr; const size_t tok = (size_t)b * SEQ + ka + 128 * kb;
                *(u32x2*)(cat + tok * 1024 + half * 256 + ct * 16 + fq * 4) = (u32x2){cvt_pk_bf16(acc[kt][0], acc[kt][1]), cvt_pk_bf16(acc[kt][2], acc[kt][3])}; }
        }
    }
    __syncthreads();
}

constexpr int VP = 160;
__device__ void natten_phase(const Params& P, LAS unsigned char* lds) {
    const int tid = threadIdx.x, wid = __builtin_amdgcn_readfirstlane(tid >> 6), lane = tid & 63, fr = lane & 15, fq = lane >> 4;
    LAS unsigned char* vimg = lds;
    LAS float* rpbs = (LAS float*)(lds + 832 * VP);
    const bf16_t* pbuf = (const bf16_t*)(P.ws + WS_BIG + BIG_P);
    bf16_t* cat = (bf16_t*)(P.ws + WS_BIG + BIG_CAT);
    const int upb = (NB * 8 * 64 + gridDim.x - 1) / gridDim.x;
    int lastbh = -1;
    for (int u = blockIdx.x * upb; u < min((int)(blockIdx.x + 1) * upb, NB * 8 * 64); ++u) {
        const int rp = u & 63, h = (u >> 6) & 7, b = u >> 9;
        const bool newbh = ((u >> 6) != lastbh); lastbh = u >> 6;
        const int rs0 = min(max(2 * rp - 4, 0), 120), rs1 = min(max(2 * rp - 3, 0), 120), nrows = rs1 - rs0 + 8;
        __syncthreads();
        {
            u32x4 tv[13];
            const int ch = tid & 7, r0 = tid >> 3;
            const bf16_t* vw = pbuf + ((size_t)b * SEQ + rs0 * 64 + r0) * PW + 1536 + h * 64 + ch * 8;
            const bf16_t* vc = pbuf + ((size_t)NT + b * CTXL + r0) * PW + 1536 + h * 64 + ch * 8;
#pragma unroll
            for (int i = 0; i < 8; ++i) tv[i] = *(const u32x4*)(vw + (size_t)i * 64 * PW);
            if (nrows == 9) tv[8] = *(const u32x4*)(vw + (size_t)8 * 64 * PW);
            if (newbh) {
#pragma unroll
                for (int i = 0; i < 4; ++i) tv[9 + i] = *(const u32x4*)(vc + (size_t)i * 64 * PW); }
#pragma unroll
            for (int i = 0; i < 8; ++i) *(LAS u32x4*)(vimg + (r0 + 64 * i) * VP + ch * 16) = tv[i];
            if (nrows == 9) *(LAS u32x4*)(vimg + (r0 + 512) * VP + ch * 16) = tv[8];
            if (newbh) {
#pragma unroll
                for (int i = 0; i < 4; ++i) *(LAS u32x4*)(vimg + (576 + r0 + 64 * i) * VP + ch * 16) = tv[9 + i]; }
        }
        if (newbh && tid < 465) rpbs[tid] = P.rpb[h * 465 + tid] * 1.44269504f;
        __syncthreads();
        const int r = 2 * rp + (wid >> 2), qt = wid & 3, c0 = (qt == 0) ? 0 : (qt == 1 ? 8 : (qt == 2 ? 24 : 32));
        const int rs = min(max(r - 4, 0), 120);
        const size_t qtok = (size_t)b * SEQ + r * 64 + qt * 16 + fr;
        const unsigned lofs = (unsigned)(fr * PW + fq * 8) * 2u;
        const char* qbase = (const char*)(pbuf + ((size_t)b * SEQ + r * 64 + qt * 16) * PW + 512 + h * 64);
        const char* kbase = (const char*)(pbuf + ((size_t)b * SEQ + rs * 64 + c0) * PW + 1024 + h * 64);
        const char* cbase = (const char*)(pbuf + ((size_t)NT + b * CTXL) * PW + 1024 + h * 64);
        const bf16x8 q0 = *(const bf16x8*)(qbase + lofs);
        const bf16x8 q1 = *(const bf16x8*)(qbase + 64 + lofs);
        f32x4 s[32];
#pragma unroll
        for (int t = 0; t < 16; ++t) {
            const unsigned toff = (unsigned)(((t >> 1) * 64 + (t & 1) * 16) * PW * 2);
            const bf16x8 k0 = *(const bf16x8*)(kbase + toff + lofs);
            const bf16x8 k1 = *(const bf16x8*)(kbase + toff + 64 + lofs);
            f32x4 a = (f32x4){0.f, 0.f, 0.f, 0.f};
            a = __builtin_amdgcn_mfma_f32_16x16x32_bf16(k0, q0, a, 0, 0, 0);
            s[t] = __builtin_amdgcn_mfma_f32_16x16x32_bf16(k1, q1, a, 0, 0, 0);
        }
#pragma unroll
        for (int t = 0; t < 16; ++t) {
            const unsigned toff = (unsigned)(t * 16 * PW * 2);
            const bf16x8 k0 = *(const bf16x8*)(cbase + toff + lofs);
            const bf16x8 k1 = *(const bf16x8*)(cbase + toff + 64 + lofs);
            f32x4 a = (f32x4){0.f, 0.f, 0.f, 0.f};
            a = __builtin_amdgcn_mfma_f32_16x16x32_bf16(k0, q0, a, 0, 0, 0);
            s[16 + t] = __builtin_amdgcn_mfma_f32_16x16x32_bf16(k1, q1, a, 0, 0, 0);
        }
        const int cq = qt * 16 + fr, cst = min(max(cq - 8, 0), 48);
        const int vlo = cst - c0 - fq * 4;
        const LAS float* brow = rpbs + (rs - r + 7) * 31 + (15 + c0 + fq * 4 - cq);
        float mx = -1e30f;
#pragma unroll
        for (int t = 0; t < 16; ++t) {
#pragma unroll
            for (int j = 0; j < 4; ++j) { const int off = (t & 1) * 16 + j;
                const float v = ((unsigned)(off - vlo) < 16u) ? s[t][j] + brow[(t >> 1) * 31 + off] : -1e30f; s[t][j] = v; mx = fmaxf(mx, v); }
        }
#pragma unroll
        for (int t = 16; t < 32; ++t)
#pragma unroll
            for (int j = 0; j < 4; ++j) mx = fmaxf(mx, s[t][j]);
        mx = fmaxf(mx, __shfl_xor(mx, 16)); mx = fmaxf(mx, __shfl_xor(mx, 32));
        float sum = 0.f;
#pragma unroll
        for (int t = 0; t < 32; ++t)
#pragma unroll
            for (int j = 0; j < 4; ++j) { const float p = __builtin_amdgcn_exp2f(s[t][j] - mx); s[t][j] = p; sum += p; }
        sum += __shfl_xor(sum, 16); sum += __shfl_xor(sum, 32);
        f32x4 o[4];
#pragma unroll
        for (int dt = 0; dt < 4; ++dt) o[dt] = (f32x4){0.f, 0.f, 0.f, 0.f};
        const int trq = (lane >> 2) & 3, trp = lane & 3;
#pragma unroll
        for (int pi = 0; pi < 16; ++pi) {
            const int t0 = 2 * pi, t1 = 2 * pi + 1;
            int rb0, rb1;
            if (pi < 8) { rb0 = (rs + pi - rs0) * 64 + c0; rb1 = rb0 + 16; } else { rb0 = 576 + (t0 - 16) * 16; rb1 = rb0 + 16; }
            bf16x8 pf; { const unsigned a0 = cvt_pk_bf16(s[t0][0], s[t0][1]), a1 = cvt_pk_bf16(s[t0][2], s[t0][3]), a2 = cvt_pk_bf16(s[t1][0], s[t1][1]), a3 = cvt_pk_bf16(s[t1][2], s[t1][3]);
                u32x4 w = (u32x4){a0, a1, a2, a3}; pf = __builtin_bit_cast(bf16x8, w); }
#pragma unroll
            for (int dt = 0; dt < 4; ++dt) {
                const s16x4 v0 = __builtin_amdgcn_ds_read_tr16_b64_v4i16((LAS s16x4*)(vimg + (rb0 + fq * 4 + trq) * VP + (dt * 16 + trp * 4) * 2));
                const s16x4 v1 = __builtin_amdgcn_ds_read_tr16_b64_v4i16((LAS s16x4*)(vimg + (rb1 + fq * 4 + trq) * VP + (dt * 16 + trp * 4) * 2));
                bf16x8 vf; vf[0] = v0[0]; vf[1] = v0[1]; vf[2] = v0[2]; vf[3] = v0[3]; vf[4] = v1[0]; vf[5] = v1[1]; vf[6] = v1[2]; vf[7] = v1[3];
                o[dt] = __builtin_amdgcn_mfma_f32_16x16x32_bf16(vf, pf, o[dt], 0, 0, 0);
            }
        }
        const float inv = 1.0f / sum;
#pragma unroll
        for (int dt = 0; dt < 4; ++dt)
            *(u32x2*)(cat + qtok * 1024 + 512 + h * 64 + dt * 16 + fq * 4) = (u32x2){cvt_pk_bf16(o[dt][0] * inv, o[dt][1] * inv), cvt_pk_bf16(o[dt][2] * inv, o[dt][3] * inv)};
    }
    __syncthreads();
}

template <int HW>
__device__ __forceinline__ void pool_item(const bf16_t* u, bf16_t* pooled, int t, int chunk) {
    const int tl = t & (SEQ - 1);
    const bf16_t* base = u + (size_t)(t - tl) * DM + chunk * 8;
    float a[8];
#pragma unroll
    for (int i = 0; i < 8; ++i) a[i] = 0.f;
    u32x4 v[2 * HW];
#pragma unroll
    for (int d = 0; d < 2 * HW; ++d) { const int r = tl - HW + d, rc = min(max(r, 0), SEQ - 1); v[d] = *(const u32x4*)(base + (size_t)rc * DM); }
#pragma unroll
    for (int d = 0; d < 2 * HW; ++d) { const int r = tl - HW + d; const float w = (r >= 0 && r < SEQ) ? 1.0f : 0.0f;
        a[0] += w * bf_lo(v[d].x); a[1] += w * bf_hi(v[d].x); a[2] += w * bf_lo(v[d].y); a[3] += w * bf_hi(v[d].y); a[4] += w * bf_lo(v[d].z); a[5] += w * bf_hi(v[d].z); a[6] += w * bf_lo(v[d].w); a[7] += w * bf_hi(v[d].w); }
    const int lo = max(tl - HW, 0), hi = min(tl + HW, SEQ);
    const float ic = 1.0f / (float)(hi - lo);
    const u32x4 c = v[HW];
    u32x4 w; w.x = cvt_pk_bf16(a[0] * ic - bf_lo(c.x), a[1] * ic - bf_hi(c.x)); w.y = cvt_pk_bf16(a[2] * ic - bf_lo(c.y), a[3] * ic - bf_hi(c.y));
    w.z = cvt_pk_bf16(a[4] * ic - bf_lo(c.z), a[5] * ic - bf_hi(c.z)); w.w = cvt_pk_bf16(a[6] * ic - bf_lo(c.w), a[7] * ic - bf_hi(c.w));
    *(u32x4*)(pooled + (size_t)t * DM + chunk * 8) = w;
}
__device__ void pool_pass(const bf16_t* u, bf16_t* pooled) {
    const int lane = threadIdx.x & 63, gw = blockIdx.x * 8 + (threadIdx.x >> 6), nw = gridDim.x * 8;
    for (int wi = gw; wi < (NT / 2) * 4; wi += nw) {
        const int gi = wi & 3, t = (wi >> 2) * 2 + (lane >> 5), chunk = gi * 32 + (lane & 31);
        if (gi == 0) pool_item<1>(u, pooled, t, chunk); else if (gi == 1) pool_item<2>(u, pooled, t, chunk); else if (gi == 2) pool_item<4>(u, pooled, t, chunk); else pool_item<8>(u, pooled, t, chunk);
    }
}

template <int HW>
__device__ __forceinline__ void pool_from_lds(const LAS unsigned char* U, bf16_t* pooled, int t0, int tl0, int tbase, int chunk) {
#pragma unroll 2
    for (int i = 0; i < 8; ++i) {
        const int t = tbase + i, tl = tl0 + t;
        float a[8];
#pragma unroll
        for (int k = 0; k < 8; ++k) a[k] = 0.f;
#pragma unroll
        for (int d = 0; d < 2 * HW; ++d) { const int r = tl - HW + d; const float w = (r >= 0 && r < SEQ) ? 1.0f : 0.0f;
            const u32x4 v = *(const LAS u32x4*)(U + (t + 8 - HW + d) * 2048 + chunk * 16);
            a[0] += w * bf_lo(v.x); a[1] += w * bf_hi(v.x); a[2] += w * bf_lo(v.y); a[3] += w * bf_hi(v.y); a[4] += w * bf_lo(v.z); a[5] += w * bf_hi(v.z); a[6] += w * bf_lo(v.w); a[7] += w * bf_hi(v.w); }
        const int lo = max(tl - HW, 0), hi = min(tl + HW, SEQ);
        const float ic = 1.0f / (float)(hi - lo);
        const u32x4 c = *(const LAS u32x4*)(U + (t + 8) * 2048 + chunk * 16);
        u32x4 w; w.x = cvt_pk_bf16(a[0] * ic - bf_lo(c.x), a[1] * ic - bf_hi(c.x)); w.y = cvt_pk_bf16(a[2] * ic - bf_lo(c.y), a[3] * ic - bf_hi(c.y));
        w.z = cvt_pk_bf16(a[4] * ic - bf_lo(c.z), a[5] * ic - bf_hi(c.z)); w.w = cvt_pk_bf16(a[6] * ic - bf_lo(c.w), a[7] * ic - bf_hi(c.w));
        *(u32x4*)(pooled + (size_t)(t0 + t) * DM + chunk * 8) = w;
    }
}
__device__ void pool_norm_fused(const bf16_t* h, const float* gn, const float* mod, bf16_t* pooled, LAS unsigned char* lds) {
    int tid = threadIdx.x; asm volatile("" : "+v"(tid));
    const int wid = tid >> 6, lane = tid & 63;
    for (int ck = blockIdx.x; ck < NT / 32; ck += gridDim.x) {
        const int t0 = ck * 32, b = t0 >> 13, tl0 = t0 & (SEQ - 1);
        f32x4 gs[4], sh[4];
        load_mod_vecs(gn, mod + (size_t)b * NMOD, mod + (size_t)b * NMOD + 1024, gs, sh, lane);
        __syncthreads();
#pragma unroll 1
        for (int rr = 0; rr < 6; rr += 2) {
            f32x4 v[2][4]; float ss[2];
#pragma unroll
            for (int q = 0; q < 2; ++q) { const int row = wid * 6 + rr + q, tl = min(max(tl0 - 8 + row, 0), SEQ - 1);
#pragma unroll
                for (int j = 0; j < 2; ++j) ld8<true>(h, ((size_t)b * SEQ + tl) * DM + j * 512 + lane * 8, v[q][2 * j], v[q][2 * j + 1]); }
#pragma unroll
            for (int q = 0; q < 2; ++q) { ss[q] = 0.f;
#pragma unroll
                for (int i = 0; i < 4; ++i) ss[q] += v[q][i][0] * v[q][i][0] + v[q][i][1] * v[q][i][1] + v[q][i][2] * v[q][i][2] + v[q][i][3] * v[q][i][3]; }
#pragma unroll
            for (int o = 32; o >= 1; o >>= 1) { ss[0] += __shfl_xor(ss[0], o); ss[1] += __shfl_xor(ss[1], o); }
#pragma unroll
            for (int q = 0; q < 2; ++q) { const float rs = rsqrtf(ss[q] * (1.0f / 1024.0f) + 1e-6f); const int row = wid * 6 + rr + q;
#pragma unroll
                for (int j = 0; j < 2; ++j) { const f32x4 a = v[q][2 * j] * rs * gs[2 * j] + sh[2 * j], c = v[q][2 * j + 1] * rs * gs[2 * j + 1] + sh[2 * j + 1];
                    u32x4 w; w.x = cvt_pk_bf16(a[0], a[1]); w.y = cvt_pk_bf16(a[2], a[3]); w.z = cvt_pk_bf16(c[0], c[1]); w.w = cvt_pk_bf16(c[2], c[3]);
                    *(LAS u32x4*)(lds + row * 2048 + (j * 512 + lane * 8) * 2) = w; } }
        }
        __syncthreads();
        const int g = wid & 3, chunk = g * 32 + (lane & 31), tbase = (wid >> 2) * 16 + (lane >> 5) * 8;
        if (g == 0) pool_from_lds<1>(lds, pooled, t0, tl0, tbase, chunk); else if (g == 1) pool_from_lds<2>(lds, pooled, t0, tl0, tbase, chunk);
        else if (g == 2) pool_from_lds<4>(lds, pooled, t0, tl0, tbase, chunk); else pool_from_lds<8>(lds, pooled, t0, tl0, tbase, chunk);
    }
    __syncthreads();
}

#define XB_TMO      128
#define XB_XCNT(j)  (256  + 64 * (j))
#define XB_XSUB(j)  (1280 + 64 * (j))
#define XB_XGEN(j)  (2304 + 64 * (j))
#define XB_TOP      3328
#define XB_TOPGEN   3392
#define XCD_BAR_WORDS 3456
#define XB_SPIN_CAP (1u << 18)
__device__ __forceinline__ unsigned xb_ld(unsigned* p)              { return __hip_atomic_load(p, __ATOMIC_RELAXED, __HIP_MEMORY_SCOPE_AGENT); }
__device__ __forceinline__ unsigned xb_add(unsigned* p, unsigned v) { return __hip_atomic_fetch_add(p, v, __ATOMIC_RELAXED, __HIP_MEMORY_SCOPE_AGENT); }
__device__ __forceinline__ unsigned xb_xcc_id() { return (unsigned)__builtin_amdgcn_s_getreg((3 << 11) | 20) & 0xFu; }
#define XB_SPIN(cond, bar) do { unsigned _sp = 0; while (cond) { __builtin_amdgcn_s_sleep(1); \
    if ((++_sp & 255u) == 0u) { if (xb_ld(&(bar)[XB_TMO])) break; if (_sp > XB_SPIN_CAP) { atomicAdd(&(bar)[XB_TMO], 1u); break; } } } } while (0)
struct XcdBarrier { unsigned* bar; unsigned x; volatile LAS unsigned* st; };
__device__ __forceinline__ XcdBarrier xcd_barrier_post(unsigned* bar, volatile LAS unsigned* st) {
    XcdBarrier b; b.bar = bar; b.x = xb_xcc_id(); b.st = st;
    if (threadIdx.x == 0) (void)xb_add(&bar[XB_XCNT(b.x)], 1u);
    return b;
}
__device__ __forceinline__ void xcd_barrier_complete(unsigned* bar, unsigned x, unsigned& nloc, unsigned& nx) {
    const unsigned G = gridDim.x * gridDim.y * gridDim.z;
    unsigned sum, cnt, mine, sp = 0u;
    for (;;) {
        sum = 0u; cnt = 0u; mine = 0u;
#pragma unroll
        for (unsigned j = 0; j < 16; ++j) { const unsigned c = xb_ld(&bar[XB_XCNT(j)]); sum += c; cnt += (c > 0u) ? 1u : 0u; mine = (j == x) ? c : mine; }
        if (sum == G) break;
        __builtin_amdgcn_s_sleep(1);
        if ((++sp & 255u) == 0u) { if (xb_ld(&bar[XB_TMO])) break; if (sp > XB_SPIN_CAP) { atomicAdd(&bar[XB_TMO], 1u); break; } }
    }
    nloc = mine > 0u ? mine : 1u; nx = cnt > 0u ? cnt : 1u;
}
__device__ __forceinline__ void xcd_barrier(const XcdBarrier& b) {
    asm volatile("s_waitcnt vmcnt(0)" ::: "memory");
    __syncthreads();
    if (threadIdx.x == 0) {
        unsigned* bar = b.bar;
        __builtin_amdgcn_s_waitcnt(0);
        unsigned nloc = b.st[0], nx = b.st[1];
        if (nloc == 0u) { xcd_barrier_complete(bar, b.x, nloc, nx); b.st[0] = nloc; b.st[1] = nx; }
        const unsigned old = xb_add(&bar[XB_XSUB(b.x)], 1u);
        const unsigned gen = old / nloc;
        if (old + 1u == (gen + 1u) * nloc) {
            __builtin_amdgcn_fence(__ATOMIC_RELEASE, "agent");
            asm volatile("s_waitcnt vmcnt(0)" ::: "memory");
            const unsigned og = xb_add(&bar[XB_TOP], 1u);
            const unsigned tg = og / nx;
            if (og + 1u == (tg + 1u) * nx) xb_add(&bar[XB_TOPGEN], 1u);
            else XB_SPIN(xb_ld(&bar[XB_TOPGEN]) == tg, bar);
            __builtin_amdgcn_fence(__ATOMIC_ACQUIRE, "agent");
            xb_add(&bar[XB_XGEN(b.x)], 1u);
            asm volatile("s_waitcnt vmcnt(0)" ::: "memory");
        } else {
            XB_SPIN(xb_ld(&bar[XB_XGEN(b.x)]) == gen, bar);
            __builtin_amdgcn_fence(__ATOMIC_ACQUIRE, "agent");
            asm volatile("s_waitcnt vmcnt(0)" ::: "memory");
        }
    }
    __syncthreads();
}

__global__ void __launch_bounds__(512, 2) fwd_megakernel(Params P) {
    extern __shared__ __attribute__((aligned(16))) unsigned char shm[];
    LAS unsigned char* lds = (LAS unsigned char*)shm;
    cg::grid_group grid = cg::this_grid();
    volatile LAS unsigned* xst = (volatile LAS unsigned*)(lds + LDS_BYTES - 16);
    if (threadIdx.x == 0) { xst[0] = 0u; xst[1] = 0u; }
    __syncthreads();
    const XcdBarrier xb = xcd_barrier_post((unsigned*)(P.ws + WS_CTL), xst);
#define GSYNC(n) xcd_barrier(xb)
    unsigned char* ws = P.ws;
    const float* mod0 = (const float*)(ws + WS_MOD0); const float* mod1 = (const float*)(ws + WS_MOD1);
    bf16_t* ubuf = (bf16_t*)(ws + WS_U);
    bf16_t* pbuf = (bf16_t*)(ws + WS_BIG + BIG_P);
    bf16_t* cat = (bf16_t*)(ws + WS_BIG + BIG_CAT);
    bf16_t* abuf = (bf16_t*)(ws + WS_BIG + BIG_A);
    bf16_t* pooled = (bf16_t*)(ws + WS_BIG + BIG_POOL);

    phase0(P, lds);
    asm volatile("s_waitcnt vmcnt(0)" ::: "memory");
    grid.sync();
    __builtin_amdgcn_fence(__ATOMIC_ACQUIRE, "agent");
    asm volatile("s_waitcnt vmcnt(0)" ::: "memory");
    bf16_t* hres = (bf16_t*)(ws + WS_H);
    norm_pass<false>(P.x, ubuf, P.norm1_g, mod0, 0, &P, hres);
    GSYNC(2);
    { Gemm g{ubuf, (const bf16_t*)(ws + WS_WIN), DM, DM, DM, (NT + NCTX) / 256, PW / 256, 0, 0, 0}; EpiProj E{pbuf, P.q_g, P.k_g}; gemm_phase(lds, g, E); }
    GSYNC(3);
    natten_phase(P, lds);
    dft_stage1(P, lds);
    GSYNC(4);
    dft_stage2(P, lds);
    GSYNC(5);
    { Gemm g{cat, (const bf16_t*)(ws + WS_WOUT), DM, DM, DM, NT / 256, DM / 256, 0, 0, 0}; EpiResT<true, true> E{hres, hres, mod0 + 2048, nullptr}; gemm_phase(lds, g, E); }
    GSYNC(6);
    norm_pass<true>(hres, ubuf, P.norm2_g, mod0, 1, nullptr);
    GSYNC(7);
    { Gemm g{ubuf, (const bf16_t*)(ws + WS_W1), DM, DM, DM, NT / 256, HID / 256, 0, 0, 0}; EpiAct E{abuf, HID}; gemm_phase(lds, g, E); }
    GSYNC(8);
    { Gemm g{abuf, (const bf16_t*)(ws + WS_W2), HID, HID, HID, NT / 256, DM / 256, 0, HID / 64, HID / 64, 1}; EpiResT<true, true> E{hres, hres, mod0 + 5120, nullptr}; gemm_phase(lds, g, E); }
    GSYNC(9);
    pool_norm_fused(hres, P.norm1_g + DM, mod1, pooled, lds);
    GSYNC(11);
    { Gemm g{pooled, (const bf16_t*)(ws + WS_WPOOL), DM, 256, 256, NT / 256, 4, 512, 0, 0}; EpiResT<true, true> E{hres, hres, mod1 + 2048, P.pool_scale}; gemm_phase(lds, g, E); }
    GSYNC(12);
    norm_pass<true>(hres, ubuf, P.norm2_g + DM, mod1, 1, nullptr);
    GSYNC(13);
    { Gemm g{ubuf, (const bf16_t*)(ws + WS_W1) + (size_t)HID * DM, DM, DM, DM, NT / 256, HID / 256, 0, 0, 0}; EpiAct E{abuf, HID}; gemm_phase(lds, g, E); }
    GSYNC(14);
    { Gemm g{abuf, (const bf16_t*)(ws + WS_W2) + (size_t)DM * HID, HID, HID, HID, NT / 256, DM / 256, 0, HID / 64, HID / 64, 1}; EpiResT<true, false> E{hres, P.out, mod1 + 5120, nullptr}; gemm_phase(lds, g, E); }
}

extern "C" void kernel_launch(void* const* d_in, const int* in_sizes, int n_in, void* d_out, int out_size, void* d_ws, size_t ws_size, hipStream_t stream) {
    static int grid_blocks = 0;
    if (grid_blocks == 0) {
        if (n_in != 18 || out_size != NT * DM || ws_size < WS_END) { fprintf(stderr, "kernel_launch: unexpected shapes (n_in %d out %d ws %zu need %zu)\n", n_in, out_size, ws_size, (size_t)WS_END); grid_blocks = -1; return; }
        int dev = 0, cus = 0, per_cu = 0;
        (void)hipGetDevice(&dev);
        (void)hipDeviceGetAttribute(&cus, hipDeviceAttributeMultiprocessorCount, dev);
        if (hipFuncSetAttribute((const void*)fwd_megakernel, hipFuncAttributeMaxDynamicSharedMemorySize, LDS_BYTES) != hipSuccess) { fprintf(stderr, "kernel_launch: hipFuncSetAttribute failed\n"); grid_blocks = -1; return; }
        if (hipOccupancyMaxActiveBlocksPerMultiprocessor(&per_cu, (const void*)fwd_megakernel, 512, LDS_BYTES) != hipSuccess || per_cu < 1) { fprintf(stderr, "kernel_launch: occupancy query failed (%d)\n", per_cu); (void)hipGetLastError(); per_cu = 1; }
        grid_blocks = cus * 1;
        (void)per_cu;
    }
    if (grid_blocks < 0) return;
    Params p{};
    p.x = (const float*)d_in[0]; p.c = (const float*)d_in[1]; p.ctx = (const float*)d_in[2]; p.c_ctx = (const float*)d_in[3]; p.w_mod = (const float*)d_in[4]; p.b_mod = (const float*)d_in[5];
    p.norm1_g = (const float*)d_in[6]; p.norm2_g = (const float*)d_in[7]; p.w_in = (const float*)d_in[8]; p.w_four = (const float*)d_in[9]; p.q_g = (const float*)d_in[10]; p.k_g = (const float*)d_in[11];
    p.rpb = (const float*)d_in[12]; p.w_out = (const float*)d_in[13]; p.w_pool = (const float*)d_in[14]; p.pool_scale = (const float*)d_in[15]; p.w_mlp1 = (const float*)d_in[16]; p.w_mlp2 = (const float*)d_in[17];
    p.out = (float*)d_out; p.ws = (unsigned char*)d_ws;
    if (hipMemsetAsync((char*)d_ws + WS_CTL, 0, 16384, stream) != hipSuccess) { fprintf(stderr, "kernel_launch: memset failed\n"); return; }
    void* args[] = {&p};
    hipError_t e = hipLaunchCooperativeKernel((const void*)fwd_megakernel, dim3(grid_blocks), dim3(512), args, LDS_BYTES, stream);
    if (e != hipSuccess) fprintf(stderr, "kernel_launch: cooperative launch failed: %s (grid %d)\n", hipGetErrorString(e), grid_blocks);
}
```

```cpp
#include <hip/hip_runtime.h>
#include <hip/hip_cooperative_groups.h>
#include <cstdio>
namespace cg = cooperative_groups;

#define LAS __attribute__((address_space(3)))
typedef unsigned short bf16_t;
typedef short bf16x8 __attribute__((ext_vector_type(8)));
typedef short s16x4 __attribute__((ext_vector_type(4)));
typedef float f32x4 __attribute__((ext_vector_type(4)));
typedef unsigned u32x4 __attribute__((ext_vector_type(4)));
typedef unsigned u32x2 __attribute__((ext_vector_type(2)));

constexpr int DM = 1024, NB = 4, SEQ = 8192, NT = NB * SEQ, CTXL = 256, NCTX = NB * CTXL, HID = 4096, NMOD = 6 * DM;
constexpr int PW = 2048;
constexpr int LDS_BYTES = 139264;

constexpr size_t al256(size_t x) { return (x + 255) & ~(size_t)255; }
constexpr size_t WS_CTL = 0;
constexpr size_t WS_MOD0 = 16384;
constexpr size_t WS_MOD1 = WS_MOD0 + al256((size_t)NB * NMOD * 4);
constexpr size_t WS_MODC = WS_MOD1 + al256((size_t)NB * NMOD * 4);
constexpr size_t WS_WIN = WS_MODC + al256(2048 * 4);
constexpr size_t WS_WOUT = WS_WIN + (size_t)PW * DM * 2;
constexpr size_t WS_W1 = WS_WOUT + (size_t)DM * DM * 2;
constexpr size_t WS_W2 = WS_W1 + (size_t)2 * HID * DM * 2;
constexpr size_t WS_WPOOL = WS_W2 + (size_t)2 * HID * DM * 2;
constexpr size_t WS_D1C = WS_WPOOL + (size_t)DM * 256 * 2;
constexpr size_t WS_D1S = WS_D1C + 128 * 128 * 2;
constexpr size_t WS_D2 = WS_D1S + 128 * 128 * 2;
constexpr size_t WS_U = WS_D2 + 64 * 128 * 2;
constexpr size_t WS_BIG = WS_U + (size_t)(NT + NCTX) * DM * 2;
constexpr size_t BIG_P = 0;
constexpr size_t BIG_S1 = BIG_P + (size_t)(NT + NCTX) * PW * 2;
constexpr size_t BIG_CAT = BIG_S1 + (size_t)NT * 1024 * 2;
constexpr size_t BIG_END = BIG_CAT + (size_t)NT * 1024 * 2;
constexpr size_t BIG_A = 0;
constexpr size_t BIG_POOL = 0;
constexpr size_t BIG_SIZE = BIG_END > (size_t)NT * HID * 2 ? BIG_END : (size_t)NT * HID * 2;
constexpr size_t WS_H = WS_BIG + BIG_SIZE;
constexpr size_t WS_END = WS_H + (size_t)NT * DM * 2;

struct Params {
    const float *x, *c, *ctx, *c_ctx, *w_mod, *b_mod, *norm1_g, *norm2_g, *w_in, *w_four, *q_g, *k_g, *rpb, *w_out, *w_pool, *pool_scale, *w_mlp1, *w_mlp2;
    float* out; unsigned char* ws;
};

typedef float f32x2 __attribute__((ext_vector_type(2)));
typedef __bf16 bf16x2v __attribute__((ext_vector_type(2)));
__device__ __forceinline__ unsigned cvt_pk_bf16(float lo, float hi) { const f32x2 f = {lo, hi}; const bf16x2v b = __builtin_convertvector(f, bf16x2v); return __builtin_bit_cast(unsigned, b); }
__device__ __forceinline__ float bf_lo(unsigned u) { return __uint_as_float(u << 16); }
__device__ __forceinline__ float bf_hi(unsigned u) { return __uint_as_float(u & 0xffff0000u); }
template <bool BF> __device__ __forceinline__ f32x4 ld4(const void* base, size_t idx) {
    if (BF) { const u32x2 v = *(const u32x2*)((const bf16_t*)base + idx); return (f32x4){bf_lo(v.x), bf_hi(v.x), bf_lo(v.y), bf_hi(v.y)}; }
    else return *(const f32x4*)((const float*)base + idx);
}
template <bool BF> __device__ __forceinline__ void st4(void* base, size_t idx, const f32x4 v) {
    if (BF) *(u32x2*)((bf16_t*)base + idx) = (u32x2){cvt_pk_bf16(v[0], v[1]), cvt_pk_bf16(v[2], v[3])};
    else *(f32x4*)((float*)base + idx) = v;
}
template <bool BF> __device__ __forceinline__ void ld8(const void* base, size_t idx, f32x4& a, f32x4& b) {
    if (BF) { const u32x4 v = *(const u32x4*)((const bf16_t*)base + idx); a = (f32x4){bf_lo(v.x), bf_hi(v.x), bf_lo(v.y), bf_hi(v.y)}; b = (f32x4){bf_lo(v.z), bf_hi(v.z), bf_lo(v.w), bf_hi(v.w)}; }
    else { a = __builtin_nontemporal_load((const f32x4*)((const float*)base + idx)); b = __builtin_nontemporal_load((const f32x4*)((const float*)base + idx + 4)); }
}
template <bool BF> __device__ __forceinline__ void st8(void* base, size_t idx, const f32x4 a, const f32x4 b) {
    if (BF) { u32x4 w; w.x = cvt_pk_bf16(a[0], a[1]); w.y = cvt_pk_bf16(a[2], a[3]); w.z = cvt_pk_bf16(b[0], b[1]); w.w = cvt_pk_bf16(b[2], b[3]); *(u32x4*)((bf16_t*)base + idx) = w; }
    else { __builtin_nontemporal_store(a, (f32x4*)((float*)base + idx)); __builtin_nontemporal_store(b, (f32x4*)((float*)base + idx + 4)); }
}
__device__ __forceinline__ int phys_row(int n, int mode) {
    const int L = n & 255, wc = L >> 6, bj = (L >> 5) & 1, j = L & 3;
    const int fq = mode ? ((L >> 2) & 3) : ((L >> 3) & 3), nn = mode ? ((L >> 4) & 1) : ((L >> 2) & 1);
    return (n & ~255) + 128 * bj + 32 * wc + 16 * nn + 4 * fq + j;
}

constexpr int BM = 256, BK = 64, HALF = 128, HTB = HALF * BK * 2, NXCD = 8, WGM = 4;
__device__ __forceinline__ int lds_byte(int r, int c) { const int st = (r >> 4) * 2 + (c >> 5), rr = r & 15, cc = c & 31, ob = rr * 64 + cc * 2; return st * 1024 + (ob ^ (((ob >> 9) & 1) << 5)); }
__device__ __forceinline__ void stage_rc(int b, int& R, int& C) { const int st = b / 1024, sb = b % 1024, swz = sb ^ (((sb >> 9) & 1) << 5); R = (st >> 1) * 16 + swz / 64; C = (st & 1) * 32 + (swz % 64) / 2; }
struct Unit { int pm, pn; };
struct Gemm { const bf16_t* A; const bf16_t* Bt; int lda, ldb, K, nM, nN, a_pn_bytes, a_blk, b_blk; int a_nt = 0; };
__device__ __forceinline__ size_t blk_off(int row, int col, int nkt) { return ((size_t)(row >> 7) * nkt + (col >> 6)) * 16384 + lds_byte(row & 127, col & 63); }
struct StaticOrder {
    int nM, nN, nwg, G, c;
    __device__ void init(int nM_, int nN_, int G_, int c_) { nM = nM_; nN = nN_; nwg = nM * nN; G = G_; c = c_; }
    __device__ bool next(int i, Unit& u) const {
        const long L = (long)i * G + c; if (L >= nwg) return false;
        int wgid = (int)L; { const int q = nwg / NXCD, r = nwg % NXCD, xcd = wgid % NXCD, off = wgid / NXCD; wgid = (xcd < r ? xcd * (q + 1) : r * (q + 1) + (xcd - r) * q) + off; }
        const int nig = WGM * nN, gid = wgid / nig, fm = gid * WGM, gsz = (nM - fm) < WGM ? (nM - fm) : WGM;
        u.pm = fm + ((wgid % nig) % gsz); u.pn = (wgid % nig) / gsz; return true;
    }
};

template <class Epi>
__device__ __forceinline__ void gemm_phase(LAS unsigned char* lds, const Gemm g, const Epi& E) {
    const int tid = threadIdx.x, wid = __builtin_amdgcn_readfirstlane(tid >> 6), lane = tid & 63, wr = wid >> 2, wc = wid & 3, fr = lane & 15, fq = lane >> 4;
    const int K = g.K, nt = K / BK;
    StaticOrder S; S.init(g.nM, g.nN, (int)gridDim.x, (int)blockIdx.x);
    unsigned voffA[2], voffB[2];
#pragma unroll
    for (int i = 0; i < 2; ++i) { int R, C; stage_rc(tid * 16 + i * 8192, R, C); voffA[i] = g.a_blk ? (unsigned)(tid * 16 + i * 8192) : (unsigned)(R * g.lda + C) * 2u; voffB[i] = g.b_blk ? (unsigned)(tid * 16 + i * 8192) : (unsigned)(R * g.ldb + C) * 2u; }
    const size_t kstepA = g.a_blk ? (size_t)16384 : (size_t)(BK * 2), kstepB = g.b_blk ? (size_t)16384 : (size_t)(BK * 2);
    const size_t hstepA = g.a_blk ? (size_t)g.a_blk * 16384 : (size_t)HALF * g.lda * 2, hstepB = g.b_blk ? (size_t)g.b_blk * 16384 : (size_t)HALF * g.ldb * 2;
    const size_t tstepA = 2 * hstepA, tstepB = 2 * hstepB;
    const unsigned ldsw = (unsigned)wid * 1024u;
    const int aoff = lds_byte(wr * 64 + fr, fq * 8), boff = lds_byte(wc * 32 + fr, fq * 8);
#define G_SA(b, h) (((b) * 2 + (h)) * HTB)
#define G_SB(b, h) ((4 + (b) * 2 + (h)) * HTB)
#define G_STAGE_A(bufoff, gbase, voff) do { if (g.a_nt) { _Pragma("unroll") for (int _i = 0; _i < 2; ++_i) \
        __builtin_amdgcn_global_load_lds((const unsigned*)((const char*)(gbase) + (voff)[_i]), (LAS unsigned*)(lds + (bufoff) + ldsw + _i * 8192), 16, 0, 2); } else { _Pragma("unroll") for (int _i = 0; _i < 2; ++_i) \
        __builtin_amdgcn_global_load_lds((const unsigned*)((const char*)(gbase) + (voff)[_i]), (LAS unsigned*)(lds + (bufoff) + ldsw + _i * 8192), 16, 0, 0); } } while (0)
#define G_STAGE(bufoff, gbase, voff) do { _Pragma("unroll") for (int _i = 0; _i < 2; ++_i) \
        __builtin_amdgcn_global_load_lds((const unsigned*)((const char*)(gbase) + (voff)[_i]), (LAS unsigned*)(lds + (bufoff) + ldsw + _i * 8192), 16, 0, 0); } while (0)
#define G_LDA(dst, b, h) do { _Pragma("unroll") for (int m = 0; m < 4; ++m) _Pragma("unroll") for (int k = 0; k < 2; ++k) dst[m][k] = *(const LAS bf16x8*)(lds + G_SA(b, h) + aoff + m * 2048 + k * 1024); } while (0)
#define G_LDB(dst, b, h) do { _Pragma("unroll") for (int n = 0; n < 2; ++n) _Pragma("unroll") for (int k = 0; k < 2; ++k) dst[n][k] = *(const LAS bf16x8*)(lds + G_SB(b, h) + boff + n * 2048 + k * 1024); } while (0)
#define G_MMA(ai, bj, At, Bt) do { __builtin_amdgcn_s_setprio(1); _Pragma("unroll") for (int m = 0; m < 4; ++m) _Pragma("unroll") for (int n = 0; n < 2; ++n) _Pragma("unroll") for (int k = 0; k < 2; ++k) \
        acc[ai][bj][m][n] = __builtin_amdgcn_mfma_f32_16x16x32_bf16(Bt[n][k], At[m][k], acc[ai][bj][m][n], 0, 0, 0); __builtin_amdgcn_s_setprio(0); } while (0)
#define G_WAIT_V(n) asm volatile("s_waitcnt vmcnt(" #n ")" ::: "memory")
#define G_WAIT_L(n) asm volatile("s_waitcnt lgkmcnt(" #n ")" ::: "memory")
#define G_BAR __builtin_amdgcn_s_barrier()
#define G_SCHED __builtin_amdgcn_sched_barrier(0)
    Unit cur, nxt; int ui = 0;
    if (!S.next(0, cur)) return;
    f32x4 acc[2][2][4][2];
#pragma unroll
    for (int a = 0; a < 2; ++a)
#pragma unroll
        for (int b = 0; b < 2; ++b)
#pragma unroll
            for (int m = 0; m < 4; ++m)
#pragma unroll
                for (int n = 0; n < 2; ++n) acc[a][b][m][n] = (f32x4){0.f, 0.f, 0.f, 0.f};
    bf16x8 At[4][2], B0[2][2], B1[2][2];
    const char* cA = (const char*)g.A + (size_t)cur.pm * tstepA + (size_t)cur.pn * g.a_pn_bytes; const char* cB = (const char*)g.Bt + (size_t)cur.pn * tstepB;
    G_STAGE(G_SB(0, 0), cB, voffB); G_STAGE_A(G_SA(0, 0), cA, voffA); G_STAGE(G_SB(0, 1), cB + hstepB, voffB); G_STAGE_A(G_SA(0, 1), cA + hstepA, voffA);
    if (wr == 1) G_BAR;
    G_WAIT_V(4); G_BAR;
    G_STAGE(G_SB(1, 0), cB + kstepB, voffB); G_STAGE_A(G_SA(1, 0), cA + kstepA, voffA); G_STAGE(G_SB(1, 1), cB + hstepB + kstepB, voffB);
    G_WAIT_V(6); G_BAR;
    for (;;) {
        const bool has_next = S.next(ui + 1, nxt);
        const char* nA = has_next ? (const char*)g.A + (size_t)nxt.pm * tstepA + (size_t)nxt.pn * g.a_pn_bytes : cA; const char* nB = has_next ? (const char*)g.Bt + (size_t)nxt.pn * tstepB : cB;
        for (int t = 0; t < nt; t += 2) {
            const bool last = (t == nt - 2);
            const char* a1 = cA + (size_t)(t + 1) * kstepA;
            const char* a2 = last ? nA : cA + (size_t)(t + 2) * kstepA; const char* b2 = last ? nB : cB + (size_t)(t + 2) * kstepB;
            const char* a3 = a2 + kstepA; const char* b3 = b2 + kstepB;
            G_LDB(B0, 0, 0); G_SCHED; G_LDA(At, 0, 0); G_STAGE_A(G_SA(1, 1), a1 + hstepA, voffA);
            G_WAIT_L(8); G_BAR; G_WAIT_L(0); G_MMA(0, 0, At, B0); G_BAR; G_SCHED;
            G_LDB(B1, 0, 1); G_STAGE(G_SB(0, 0), b2, voffB);
            G_BAR; G_WAIT_L(0); G_MMA(0, 1, At, B1); G_BAR;
            G_LDA(At, 0, 1); G_STAGE_A(G_SA(0, 0), a2, voffA);
            G_BAR; G_WAIT_L(0); G_MMA(1, 0, At, B0); G_BAR; G_SCHED;
            G_STAGE(G_SB(0, 1), b2 + hstepB, voffB);
            G_WAIT_V(6); G_BAR; G_MMA(1, 1, At, B1); G_BAR;
            G_LDB(B0, 1, 0); G_SCHED; G_LDA(At, 1, 0); G_STAGE_A(G_SA(0, 1), a2 + hstepA, voffA);
            G_WAIT_L(8); G_BAR; G_WAIT_L(0); G_MMA(0, 0, At, B0); G_BAR; G_SCHED;
            G_LDB(B1, 1, 1); G_STAGE(G_SB(1, 0), b3, voffB);
            G_BAR; G_WAIT_L(0); G_MMA(0, 1, At, B1); G_BAR;
            G_LDA(At, 1, 1); G_STAGE_A(G_SA(1, 0), a3, voffA);
            G_BAR; G_WAIT_L(0); G_MMA(1, 0, At, B0); G_BAR; G_SCHED;
            G_STAGE(G_SB(1, 1), b3 + hstepB, voffB);
            G_WAIT_V(6); G_BAR; G_MMA(1, 1, At, B1); G_BAR;
        }
        E(acc, cur, wr, wc, fr, fq);
        if (!has_next) break;
#pragma unroll
        for (int a = 0; a < 2; ++a)
#pragma unroll
            for (int b = 0; b < 2; ++b)
#pragma unroll
                for (int m = 0; m < 4; ++m)
#pragma unroll
                    for (int n = 0; n < 2; ++n) acc[a][b][m][n] = (f32x4){0.f, 0.f, 0.f, 0.f};
        cur = nxt; cA = nA; cB = nB; ++ui;
    }
    G_WAIT_V(0);
    if (wr == 0) G_BAR;
    G_BAR;
#undef G_SA
#undef G_SB
#undef G_STAGE
#undef G_STAGE_A
#undef G_LDA
#undef G_LDB
#undef G_MMA
#undef G_WAIT_V
#undef G_WAIT_L
#undef G_BAR
#undef G_SCHED
}

__device__ __forceinline__ void store16_bf16(bf16_t* dst, const float (&v)[16]) {
    u32x4 w0, w1;
    w0.x = cvt_pk_bf16(v[0], v[1]); w0.y = cvt_pk_bf16(v[2], v[3]); w0.z = cvt_pk_bf16(v[4], v[5]); w0.w = cvt_pk_bf16(v[6], v[7]);
    w1.x = cvt_pk_bf16(v[8], v[9]); w1.y = cvt_pk_bf16(v[10], v[11]); w1.z = cvt_pk_bf16(v[12], v[13]); w1.w = cvt_pk_bf16(v[14], v[15]);
    *(u32x4*)dst = w0; *(u32x4*)(dst + 8) = w1;
}
__device__ __forceinline__ void store8_bf16(bf16_t* dst, const f32x4 a, const f32x4 b) {
    u32x4 w; w.x = cvt_pk_bf16(a[0], a[1]); w.y = cvt_pk_bf16(a[2], a[3]); w.z = cvt_pk_bf16(b[0], b[1]); w.w = cvt_pk_bf16(b[2], b[3]);
    *(u32x4*)dst = w;
}
__device__ __forceinline__ void store8_bf16_nt(bf16_t* dst, const f32x4 a, const f32x4 b) {
    u32x4 w; w.x = cvt_pk_bf16(a[0], a[1]); w.y = cvt_pk_bf16(a[2], a[3]); w.z = cvt_pk_bf16(b[0], b[1]); w.w = cvt_pk_bf16(b[2], b[3]);
    __builtin_nontemporal_store(w, (u32x4*)dst);
}
struct EpiProj {
    bf16_t* P; const float* qg; const float* kg;
    __device__ __forceinline__ void operator()(const f32x4 (&acc)[2][2][4][2], const Unit& u, int wr, int wc, int fr, int fq) const {
        const int row0 = u.pm * BM + wr * 64 + fr, col0 = u.pn * BM + wc * 64 + fq * 8;
        const bool hn = (u.pn >= 2 && u.pn < 6);
        const float qs = (u.pn < 4) ? 0.18033688011112042f : 1.0f;
        f32x4 gv[2][2];
        if (hn) { const float* gp = (u.pn < 4 ? qg : kg) + fq * 8;
#pragma unroll
            for (int bj = 0; bj < 2; ++bj)
#pragma unroll
                for (int n = 0; n < 2; ++n) gv[bj][n] = *(const f32x4*)(gp + 32 * bj + 4 * n); }
#pragma unroll
        for (int ai = 0; ai < 2; ++ai)
#pragma unroll
            for (int m = 0; m < 4; ++m) {
                f32x4 v[2][2];
#pragma unroll
                for (int bj = 0; bj < 2; ++bj)
#pragma unroll
                    for (int n = 0; n < 2; ++n) v[bj][n] = acc[ai][bj][m][n];
                if (hn) {
                    float ss = 0.f;
#pragma unroll
                    for (int bj = 0; bj < 2; ++bj)
#pragma unroll
                        for (int n = 0; n < 2; ++n) ss += v[bj][n][0] * v[bj][n][0] + v[bj][n][1] * v[bj][n][1] + v[bj][n][2] * v[bj][n][2] + v[bj][n][3] * v[bj][n][3];
                    ss += __shfl_xor(ss, 16); ss += __shfl_xor(ss, 32);
                    const float rs = rsqrtf(ss * (1.0f / 64.0f) + 1e-6f);
#pragma unroll
                    for (int bj = 0; bj < 2; ++bj)
#pragma unroll
                        for (int n = 0; n < 2; ++n) v[bj][n] = v[bj][n] * (rs * qs) * gv[bj][n];
                }
                bf16_t* dst = P + (size_t)(row0 + ai * HALF + m * 16) * PW + col0;
                store8_bf16(dst, v[0][0], v[0][1]); store8_bf16(dst + 32, v[1][0], v[1][1]);
            }
    }
};
struct EpiAct {
    bf16_t* O; int ldo;
    __device__ __forceinline__ void operator()(const f32x4 (&acc)[2][2][4][2], const Unit& u, int wr, int wc, int fr, int fq) const {
        const int row0 = u.pm * BM + wr * 64 + fr, col0 = u.pn * BM + wc * 64 + fq * 8;
#pragma unroll
        for (int ai = 0; ai < 2; ++ai)
#pragma unroll
            for (int m = 0; m < 4; ++m) {
                const int row = row0 + ai * HALF + m * 16;
#pragma unroll
                for (int bj = 0; bj < 2; ++bj) { f32x4 a = acc[ai][bj][m][0], b = acc[ai][bj][m][1];
                    bf16_t* dst = (bf16_t*)((char*)O + blk_off(row, col0 + 32 * bj, ldo / 64));
#pragma unroll
                    for (int j = 0; j < 4; ++j) { const float ra = fmaxf(a[j], 0.f), rb = fmaxf(b[j], 0.f); a[j] = ra * ra; b[j] = rb * rb; }
                    store8_bf16_nt(dst, a, b); }
            }
    }
};
template <bool RB, bool OB> struct EpiResT {
    const void* res; void* out; const float* gate; const float* cscale;
    __device__ __forceinline__ void operator()(const f32x4 (&acc)[2][2][4][2], const Unit& u, int wr, int wc, int fr, int fq) const {
        const int row0 = u.pm * BM + wr * 64 + fr, col0 = u.pn * BM + wc * 64 + fq * 8;
        const int b = u.pm >> 5;
        f32x4 gv[2][2];
#pragma unroll
        for (int bj = 0; bj < 2; ++bj)
#pragma unroll
            for (int n = 0; n < 2; ++n) { f32x4 t = *(const f32x4*)(gate + (size_t)b * NMOD + col0 + 32 * bj + 4 * n);
                if (cscale) { const f32x4 s = *(const f32x4*)(cscale + col0 + 32 * bj + 4 * n); t = t * s; }
                gv[bj][n] = t; }
#pragma unroll
        for (int ai = 0; ai < 2; ++ai)
#pragma unroll
            for (int m = 0; m < 4; ++m) {
                const size_t off = (size_t)(row0 + ai * HALF + m * 16) * DM + col0;
#pragma unroll
                for (int bj = 0; bj < 2; ++bj) { f32x4 r0, r1; ld8<RB>(res, off + 32 * bj, r0, r1);
                    st8<OB>(out, off + 32 * bj, r0 + gv[bj][0] * acc[ai][bj][m][0], r1 + gv[bj][1] * acc[ai][bj][m][1]); }
            }
    }
};

__device__ void mod_task(const Params& P, int t, LAS float* sl) {
    const int tid = threadIdx.x, l = t / 96, n0 = (t % 96) * 64;
#pragma unroll
    for (int i = tid; i < 5 * 1024; i += 512) { const float v = (i < 4096) ? P.c[i] : P.c_ctx[i - 4096]; sl[i] = v / (1.0f + expf(-v)); }
    __syncthreads();
    const int kg = tid >> 6, ln = tid & 63;
    const float* w = P.w_mod + (size_t)l * DM * NMOD + n0 + ln;
    float a0 = 0.f, a1 = 0.f, a2 = 0.f, a3 = 0.f, a4 = 0.f;
#pragma unroll 8
    for (int k = kg * 128; k < kg * 128 + 128; ++k) { const float wv = __builtin_nontemporal_load(w + (size_t)k * NMOD); a0 += sl[k] * wv; a1 += sl[1024 + k] * wv; a2 += sl[2048 + k] * wv; a3 += sl[3072 + k] * wv; a4 += sl[4096 + k] * wv; }
    LAS float* red = sl + 5 * 1024;
    red[(kg * 5 + 0) * 64 + ln] = a0; red[(kg * 5 + 1) * 64 + ln] = a1; red[(kg * 5 + 2) * 64 + ln] = a2; red[(kg * 5 + 3) * 64 + ln] = a3; red[(kg * 5 + 4) * 64 + ln] = a4;
    __syncthreads();
    if (tid < 320) { const int r = tid >> 6, n = tid & 63; float s = 0.f;
        for (int g = 0; g < 8; ++g) s += red[(g * 5 + r) * 64 + n];
        s += P.b_mod[l * NMOD + n0 + n];
        float* modl = (float*)(P.ws + (l ? WS_MOD1 : WS_MOD0));
        if (r < 4) modl[r * NMOD + n0 + n] = s; else if (l == 0 && n0 + n < 2048) ((float*)(P.ws + WS_MODC))[n0 + n] = s; }
    __syncthreads();
}
__device__ void fold_win_task(const Params& P, int t, LAS float* sl) {
    const int tid = threadIdx.x, g = t >> 4, k0 = (t & 15) * 64;
    LAS float* wt = sl;
    LAS float* ctab = sl + 64 * 132;
    { const int r = tid >> 5, c4 = tid & 31;
#pragma unroll
        for (int i = 0; i < 4; ++i) { const f32x4 v = *(const f32x4*)(P.w_in + (size_t)(k0 + r + 16 * i) * PW + g * 128 + c4 * 4); LAS float* d = wt + (r + 16 * i) * 132 + c4 * 4; d[0] = v[0]; d[1] = v[1]; d[2] = v[2]; d[3] = v[3]; } }
    if (tid < 128) ctab[tid] = cospif((float)tid * (1.0f / 64.0f));
    __syncthreads();
    const int jj = tid & 127, kq = tid >> 7;
    float acc[16];
#pragma unroll
    for (int i = 0; i < 16; ++i) acc[i] = 0.f;
    const int mul = (jj <= 64) ? jj : (jj - 64), sub = (jj <= 64) ? 0 : 32;
    for (int c = 0; c < 128; c += 4) {
        const float d0 = ctab[(mul * c - sub) & 127], d1 = ctab[(mul * (c + 1) - sub) & 127], d2 = ctab[(mul * (c + 2) - sub) & 127], d3 = ctab[(mul * (c + 3) - sub) & 127];
#pragma unroll
        for (int i = 0; i < 16; ++i) { const f32x4 w = *(const LAS f32x4*)(wt + (kq * 16 + i) * 132 + c); acc[i] += w[0] * d0 + w[1] * d1 + w[2] * d2 + w[3] * d3; }
    }
    bf16_t* dst = (bf16_t*)(P.ws + WS_WIN) + (size_t)phys_row(g * 128 + jj, 0) * DM + k0 + kq * 16;
    store16_bf16(dst, acc);
    __syncthreads();
}
__device__ void fold_wout_task(const Params& P, int t, LAS float* sl) {
    const int tid = threadIdx.x, g = t >> 4, d0 = (t & 15) * 64;
    LAS float* wfp = sl;
    LAS float* wo = sl + 128 * 128;
    const float* base = P.w_four + (size_t)g * 128 * 128;
#pragma unroll 8
    for (int idx = tid; idx < 128 * 128; idx += 512) { const int jj = idx >> 7, e = idx & 127; float v;
        if (jj == 0 || jj == 64) v = base[jj * 128 + e];
        else if (jj < 64) v = base[jj * 128 + e] + base[(128 - jj) * 128 + e];
        else { const int l = jj - 64; v = base[(128 - l) * 128 + e] - base[l * 128 + e]; }
        wfp[idx] = v; }
    { const int r = tid >> 4, c4 = tid & 15;
#pragma unroll
        for (int i = 0; i < 4; ++i) { const f32x4 v = *(const f32x4*)(P.w_out + (size_t)(g * 128 + r + 32 * i) * DM + d0 + c4 * 4); LAS float* d = wo + (r + 32 * i) * 64 + c4 * 4; d[0] = v[0]; d[1] = v[1]; d[2] = v[2]; d[3] = v[3]; } }
    __syncthreads();
    const int dd = tid & 63, jq = tid >> 6;
    float acc[16];
#pragma unroll
    for (int i = 0; i < 16; ++i) acc[i] = 0.f;
    for (int e = 0; e < 128; e += 4) {
        const float w0 = wo[e * 64 + dd], w1 = wo[(e + 1) * 64 + dd], w2 = wo[(e + 2) * 64 + dd], w3 = wo[(e + 3) * 64 + dd];
#pragma unroll
        for (int i = 0; i < 16; ++i) { const f32x4 f = *(const LAS f32x4*)(wfp + (jq * 16 + i) * 128 + e); acc[i] += f[0] * w0 + f[1] * w1 + f[2] * w2 + f[3] * w3; }
    }
    bf16_t* dst = (bf16_t*)(P.ws + WS_WOUT) + (size_t)phys_row(d0 + dd, 0) * DM + g * 128 + jq * 16;
    store16_bf16(dst, acc);
    __syncthreads();
}
__device__ void conv_tile(const float* src, int ld, int k0, int n0, bf16_t* dst, int ldd, int kdst0, int ndst0, int mode, LAS float* sl, int blocked = 0) {
    const int tid = threadIdx.x;
    { const int r = tid >> 4, c4 = tid & 15;
        f32x4 v[4][2];
#pragma unroll
        for (int t = 0; t < 4; ++t)
#pragma unroll
            for (int i = 0; i < 2; ++i) v[t][i] = __builtin_nontemporal_load((const f32x4*)(src + (size_t)(k0 + r + 32 * i) * ld + n0 + t * 64 + c4 * 4));
#pragma unroll
        for (int t = 0; t < 4; ++t)
#pragma unroll
            for (int i = 0; i < 2; ++i) { LAS float* d = sl + t * (64 * 65) + (r + 32 * i) * 65 + c4 * 4; d[0] = v[t][i][0]; d[1] = v[t][i][1]; d[2] = v[t][i][2]; d[3] = v[t][i][3]; } }
    __syncthreads();
    { const int nn = tid >> 3, kc = tid & 7;
#pragma unroll
        for (int t = 0; t < 4; ++t) { float v[8];
#pragma unroll
            for (int i = 0; i < 8; ++i) v[i] = sl[t * (64 * 65) + (kc * 8 + i) * 65 + nn];
            u32x4 w; w.x = cvt_pk_bf16(v[0], v[1]); w.y = cvt_pk_bf16(v[2], v[3]); w.z = cvt_pk_bf16(v[4], v[5]); w.w = cvt_pk_bf16(v[6], v[7]);
            const int prow = phys_row(ndst0 + n0 + t * 64 + nn, mode), pcol = kdst0 + k0 + kc * 8;
            if (blocked) *(u32x4*)((char*)dst + blk_off(prow, pcol, ldd / 64)) = w; else *(u32x4*)(dst + (size_t)prow * ldd + pcol) = w; } }
    __syncthreads();
}
__device__ void dft_tab_task(const Params& P) {
    bf16_t* d1c = (bf16_t*)(P.ws + WS_D1C); bf16_t* d1s = (bf16_t*)(P.ws + WS_D1S); bf16_t* d2 = (bf16_t*)(P.ws + WS_D2);
    for (int idx = threadIdx.x; idx < 128 * 128; idx += 512) { const int ka = idx >> 7, a = idx & 127; const float ang = (float)((ka * a) & 127) * (1.0f / 64.0f);
        d1c[idx] = (bf16_t)(cvt_pk_bf16(cospif(ang), 0.f) & 0xffff); d1s[idx] = (bf16_t)(cvt_pk_bf16(-sinpif(ang), 0.f) & 0xffff); }
    for (int idx = threadIdx.x; idx < 64 * 128; idx += 512) { const int kb = idx >> 7, kk = idx & 127, bb = kk >> 1; const float ang = (float)((kb * bb) & 63) * (1.0f / 32.0f);
        const float v = ((kk & 1) ? sinpif(ang) : cospif(ang)) * (1.0f / 32.0f);
        d2[idx] = (bf16_t)(cvt_pk_bf16(v, 0.f) & 0xffff); }
}
__device__ void phase0(const Params& P, LAS unsigned char* lds) {
    LAS float* sl = (LAS float*)lds;
    constexpr int T_MOD = 192, T_FWIN = 64, T_FWOUT = 64, T_W1 = 512, T_W2 = 512, T_WIN = 96, T_WOUT = 32, T_POOL = 16, T_DFT = 1;
    constexpr int NTASK = T_MOD + T_FWIN + T_FWOUT + T_W1 + T_W2 + T_WIN + T_WOUT + T_POOL + T_DFT;
    unsigned* qhead = (unsigned*)(P.ws + WS_CTL) + 3600;
    volatile LAS unsigned* qslot = (volatile LAS unsigned*)(lds + LDS_BYTES - 8);
    for (;;) {
        __syncthreads();
        if (threadIdx.x == 0) *qslot = __hip_atomic_fetch_add(qhead, 1u, __ATOMIC_RELAXED, __HIP_MEMORY_SCOPE_AGENT);
        __syncthreads();
        const int t = (int)*qslot;
        if (t >= NTASK) break;
        int q = t;
        if (q < T_MOD) { mod_task(P, q, sl); continue; } q -= T_MOD;
        if (q < T_FWIN) { fold_win_task(P, q, sl); continue; } q -= T_FWIN;
        if (q < T_FWOUT) { fold_wout_task(P, q, sl); continue; } q -= T_FWOUT;
        if (q < T_W1) { const int l = q >> 8, r = q & 255, kt = r >> 4, ntile = r & 15;
            conv_tile(P.w_mlp1 + (size_t)l * DM * HID, HID, kt * 64, ntile * 256, (bf16_t*)(P.ws + WS_W1) + (size_t)l * HID * DM, DM, 0, 0, 0, sl); continue; } q -= T_W1;
        if (q < T_W2) { const int l = q >> 8, r = q & 255, kt = r >> 2, ntile = r & 3;
            conv_tile(P.w_mlp2 + (size_t)l * HID * DM, DM, kt * 64, ntile * 256, (bf16_t*)(P.ws + WS_W2) + (size_t)l * DM * HID, HID, 0, 0, 0, sl, 1); continue; } q -= T_W2;
        if (q < T_WIN) { const int kt = q / 6, ntile = q % 6;
            conv_tile(P.w_in, PW, kt * 64, 512 + ntile * 256, (bf16_t*)(P.ws + WS_WIN), DM, 0, 0, 0, sl); continue; } q -= T_WIN;
        if (q < T_WOUT) { const int kt = q >> 2, ntile = q & 3;
            conv_tile(P.w_out + (size_t)512 * DM, DM, kt * 64, ntile * 256, (bf16_t*)(P.ws + WS_WOUT), DM, 512, 0, 0, sl); continue; } q -= T_WOUT;
        if (q < T_POOL) { const int g = q >> 2, kt = q & 3;
            conv_tile(P.w_pool + (size_t)g * 256 * 256, 256, kt * 64, 0, (bf16_t*)(P.ws + WS_WPOOL), 256, 0, g * 256, 0, sl); continue; } q -= T_POOL;
        dft_tab_task(P);
    }
}

template <int NR, bool SB>
__device__ __forceinline__ void norm_rows(const void* src, size_t srow, bf16_t* dst, const f32x4 (&gs)[4], const f32x4 (&sh)[4], int lane, bf16_t* cpy = nullptr) {
    f32x4 v[NR][4]; float ss[NR];
#pragma unroll
    for (int r = 0; r < NR; ++r)
#pragma unroll
        for (int j = 0; j < 2; ++j) ld8<SB>(src, (srow + r) * DM + j * 512 + lane * 8, v[r][2 * j], v[r][2 * j + 1]);
#pragma unroll
    for (int r = 0; r < NR; ++r) { ss[r] = 0.f;
#pragma unroll
        for (int i = 0; i < 4; ++i) ss[r] += v[r][i][0] * v[r][i][0] + v[r][i][1] * v[r][i][1] + v[r][i][2] * v[r][i][2] + v[r][i][3] * v[r][i][3]; }
#pragma unroll
    for (int o = 32; o >= 1; o >>= 1)
#pragma unroll
        for (int r = 0; r < NR; ++r) ss[r] += __shfl_xor(ss[r], o);
#pragma unroll
    for (int r = 0; r < NR; ++r) { const float rs = rsqrtf(ss[r] * (1.0f / 1024.0f) + 1e-6f);
#pragma unroll
        for (int j = 0; j < 2; ++j) { const f32x4 a = v[r][2 * j] * rs * gs[2 * j] + sh[2 * j], b = v[r][2 * j + 1] * rs * gs[2 * j + 1] + sh[2 * j + 1];
            st8<true>(dst, (size_t)r * DM + j * 512 + lane * 8, a, b);
            if (cpy) st8<true>(cpy, (size_t)r * DM + j * 512 + lane * 8, v[r][2 * j], v[r][2 * j + 1]); } }
}
__device__ __forceinline__ void load_mod_vecs(const float* gn, const float* shift, const float* scale, f32x4 (&gs)[4], f32x4 (&sh)[4], int lane) {
#pragma unroll
    for (int i = 0; i < 4; ++i) { const int c = (i >> 1) * 512 + lane * 8 + (i & 1) * 4; const f32x4 g = *(const f32x4*)(gn + c), s = *(const f32x4*)(scale + c); gs[i] = g * (s + 1.0f); sh[i] = *(const f32x4*)(shift + c); }
}
template <bool SB>
__device__ __forceinline__ void norm_pass(const void* src, bf16_t* dst, const float* gn, const float* mod, int which, const Params* Pctx, bf16_t* cpy = nullptr) {
    int ltid_ = threadIdx.x; asm volatile("" : "+v"(ltid_));
    const int lane = ltid_ & 63, gw = blockIdx.x * 8 + (ltid_ >> 6), nw = gridDim.x * 8;
    f32x4 gs[4], sh[4];
    int curb = -1;
    for (int r = gw * 4; r < NT; r += nw * 4) {
        const int b = r >> 13;
        if (b != curb) { curb = b; load_mod_vecs(gn, mod + (size_t)b * NMOD + which * 3072, mod + (size_t)b * NMOD + which * 3072 + 1024, gs, sh, lane); }
        norm_rows<4, SB>(src, (size_t)r, dst + (size_t)r * DM, gs, sh, lane, cpy ? cpy + (size_t)r * DM : nullptr);
    }
    if (Pctx) {
        const float* modc = (const float*)(Pctx->ws + WS_MODC);
        load_mod_vecs(gn, modc, modc + 1024, gs, sh, lane);
        for (int r = gw; r < NCTX; r += nw) norm_rows<1, false>(Pctx->ctx, (size_t)r, dst + (size_t)(NT + r) * DM, gs, sh, lane);
    }
}

constexpr int ACT_PITCH = 260;
__device__ __forceinline__ void dft_load_tile(const bf16_t* src, size_t row_stride, LAS unsigned char* act) {
    const int tid = threadIdx.x, chunk = tid & 31, r0 = tid >> 5;
#pragma unroll
    for (int i = 0; i < 8; ++i) { const int r = r0 + 16 * i; const u32x4 v = *(const u32x4*)(src + (size_t)r * row_stride + chunk * 8);
        LAS u32x2* d = (LAS u32x2*)(act + r * (ACT_PITCH * 2) + chunk * 16); d[0] = (u32x2){v.x, v.y}; d[1] = (u32x2){v.z, v.w}; }
}
__device__ __forceinline__ bf16x8 dft_gather(const LAS unsigned char* act, int kc, int fq, int ch) {
    const LAS bf16_t* p = (const LAS bf16_t*)act + (kc * 32 + fq * 8) * ACT_PITCH + ch;
    bf16x8 r;
#pragma unroll
    for (int i = 0; i < 8; ++i) r[i] = (short)p[i * ACT_PITCH];
    return r;
}
__device__ void dft_stage1(const Params& P, LAS unsigned char* lds) {
    const int tid = threadIdx.x, wid = tid >> 6, lane = tid & 63, fr = lane & 15, fq = lane >> 4;
    LAS unsigned char* d1c = lds; LAS unsigned char* d1s = lds + 34816; LAS unsigned char* act = lds + 69632;
    __syncthreads();
#pragma unroll
    for (int id = tid; id < 2 * 2048; id += 512) { const int mtx = id >> 11, r = (id >> 4) & 127, ch = id & 15;
        const u32x4 v = *(const u32x4*)(P.ws + (mtx ? WS_D1S : WS_D1C) + r * 256 + ch * 16);
        *(LAS u32x4*)((mtx ? d1s : d1c) + r * 272 + ch * 16) = v; }
    const bf16_t* pbuf = (const bf16_t*)(P.ws + WS_BIG + BIG_P);
    bf16_t* s1 = (bf16_t*)(P.ws + WS_BIG + BIG_S1);
    for (int u = blockIdx.x; u < NB * 64 * 2; u += gridDim.x) {
        const int half = u & 1, bb = (u >> 1) & 63, b = u >> 7;
        __syncthreads();
        dft_load_tile(pbuf + ((size_t)b * SEQ + bb) * PW + half * 256, (size_t)64 * PW, act);
        __syncthreads();
#pragma unroll 1
        for (int cti = 0; cti < 2; ++cti) {
            const int ct = wid * 2 + cti;
            bf16x8 af[4];
#pragma unroll
            for (int kc = 0; kc < 4; ++kc) af[kc] = dft_gather(act, kc, fq, ct * 16 + fr);
            const int chg = half * 256 + ct * 16 + fq * 4;
#pragma unroll 1
            for (int kt = 0; kt < 8; ++kt) {
                f32x4 aR = (f32x4){0.f, 0.f, 0.f, 0.f}, aI = (f32x4){0.f, 0.f, 0.f, 0.f};
#pragma unroll
                for (int kc = 0; kc < 4; ++kc) {
                    const bf16x8 bc = *(const LAS bf16x8*)(d1c + (kt * 16 + fr) * 272 + (kc * 32 + fq * 8) * 2);
                    const bf16x8 bs = *(const LAS bf16x8*)(d1s + (kt * 16 + fr) * 272 + (kc * 32 + fq * 8) * 2);
                    aR = __builtin_amdgcn_mfma_f32_16x16x32_bf16(af[kc], bc, aR, 0, 0, 0);
                    aI = __builtin_amdgcn_mfma_f32_16x16x32_bf16(af[kc], bs, aI, 0, 0, 0);
                }
                const int ka = kt * 16 + fr;
                float sph, cph; sincospif((float)((ka * bb) & 8191) * (1.0f / 4096.0f), &sph, &cph);
                cph *= (1.0f / 32.0f); sph *= (1.0f / 32.0f);
                float re[4], im[4];
#pragma unroll
                for (int j = 0; j < 4; ++j) { const float x = aR[j], y = aI[j]; const float r0 = x * cph + y * sph, i0 = y * cph - x * sph;
                    const bool isq = ((chg + j) & 127) > 64; re[j] = isq ? -i0 : r0; im[j] = isq ? r0 : i0; }
                bf16_t* d = s1 + ((((size_t)b * 128 + ka) * 64 + bb) * 2) * 512 + chg;
                *(u32x2*)d = (u32x2){cvt_pk_bf16(re[0], re[1]), cvt_pk_bf16(re[2], re[3])};
                *(u32x2*)(d + 512) = (u32x2){cvt_pk_bf16(im[0], im[1]), cvt_pk_bf16(im[2], im[3])};
            }
        }
    }
    __syncthreads();
}
__device__ void dft_stage2(const Params& P, LAS unsigned char* lds) {
    const int tid = threadIdx.x, wid = tid >> 6, lane = tid & 63, fr = lane & 15, fq = lane >> 4;
    LAS unsigned char* d2 = lds; LAS unsigned char* act = lds + 17408;
    __syncthreads();
#pragma unroll
    for (int id = tid; id < 1024; id += 512) { const int r = id >> 4, ch = id & 15; *(LAS u32x4*)(d2 + r * 272 + ch * 16) = *(const u32x4*)(P.ws + WS_D2 + r * 256 + ch * 16); }
    const bf16_t* s1 = (const bf16_t*)(P.ws + WS_BIG + BIG_S1);
    bf16_t* cat = (bf16_t*)(P.ws + WS_BIG + BIG_CAT);
    for (int u = blockIdx.x; u < NB * 128 * 2; u += gridDim.x) {
        const int half = u & 1, ka = (u >> 1) & 127, b = u >> 8;
        __syncthreads();
        dft_load_tile(s1 + (((size_t)b * 128 + ka) * 128) * 512 + half * 256, 512, act);
        __syncthreads();
#pragma unroll 1
        for (int cti = 0; cti < 2; ++cti) {
            const int ct = wid * 2 + cti;
            bf16x8 af[4];
#pragma unroll
            for (int kc = 0; kc < 4; ++kc) af[kc] = dft_gather(act, kc, fq, ct * 16 + fr);
            f32x4 acc[4];
#pragma unroll
            for (int kt = 0; kt < 4; ++kt) acc[kt] = (f32x4){0.f, 0.f, 0.f, 0.f};
#pragma unroll
            for (int kt = 0; kt < 4; ++kt)
#pragma unroll
                for (int kc = 0; kc < 4; ++kc) {
                    const bf16x8 bv = *(const LAS bf16x8*)(d2 + (kt * 16 + fr) * 272 + (kc * 32 + fq * 8) * 2);
                    acc[kt] = __builtin_amdgcn_mfma_f32_16x16x32_bf16(af[kc], bv, acc[kt], 0, 0, 0);
                }
#pragma unroll
            for (int kt = 0; kt < 4; ++kt) { const int kb = kt * 16 + fr; const size_t tok = (size_t)b * SEQ + ka + 128 * kb;
                *(u32x2*)(cat + tok * 1024 + half * 256 + ct * 16 + fq * 4) = (u32x2){cvt_pk_bf16(acc[kt][0], acc[kt][1]), cvt_pk_bf16(acc[kt][2], acc[kt][3])}; }
        }
    }
    __syncthreads();
}

constexpr int VP = 160;
__device__ void natten_phase(const Params& P, LAS unsigned char* lds) {
    const int tid = threadIdx.x, wid = __builtin_amdgcn_readfirstlane(tid >> 6), lane = tid & 63, fr = lane & 15, fq = lane >> 4;
    LAS unsigned char* vimg = lds;
    LAS float* rpbs = (LAS float*)(lds + 832 * VP);
    const bf16_t* pbuf = (const bf16_t*)(P.ws + WS_BIG + BIG_P);
    bf16_t* cat = (bf16_t*)(P.ws + WS_BIG + BIG_CAT);
    const int upb = (NB * 8 * 64 + gridDim.x - 1) / gridDim.x;
    int lastbh = -1;
    for (int u = blockIdx.x * upb; u < min((int)(blockIdx.x + 1) * upb, NB * 8 * 64); ++u) {
        const int rp = u & 63, h = (u >> 6) & 7, b = u >> 9;
        const bool newbh = ((u >> 6) != lastbh); lastbh = u >> 6;
        const int rs0 = min(max(2 * rp - 4, 0), 120), rs1 = min(max(2 * rp - 3, 0), 120), nrows = rs1 - rs0 + 8;
        __syncthreads();
        {
            u32x4 tv[13];
            const int ch = tid & 7, r0 = tid >> 3;
            const bf16_t* vw = pbuf + ((size_t)b * SEQ + rs0 * 64 + r0) * PW + 1536 + h * 64 + ch * 8;
            const bf16_t* vc = pbuf + ((size_t)NT + b * CTXL + r0) * PW + 1536 + h * 64 + ch * 8;
#pragma unroll
            for (int i = 0; i < 8; ++i) tv[i] = *(const u32x4*)(vw + (size_t)i * 64 * PW);
            if (nrows == 9) tv[8] = *(const u32x4*)(vw + (size_t)8 * 64 * PW);
            if (newbh) {
#pragma unroll
                for (int i = 0; i < 4; ++i) tv[9 + i] = *(const u32x4*)(vc + (size_t)i * 64 * PW); }
#pragma unroll
            for (int i = 0; i < 8; ++i) *(LAS u32x4*)(vimg + (r0 + 64 * i) * VP + ch * 16) = tv[i];
            if (nrows == 9) *(LAS u32x4*)(vimg + (r0 + 512) * VP + ch * 16) = tv[8];
            if (newbh) {
#pragma unroll
                for (int i = 0; i < 4; ++i) *(LAS u32x4*)(vimg + (576 + r0 + 64 * i) * VP + ch * 16) = tv[9 + i]; }
        }
        if (newbh && tid < 465) rpbs[tid] = P.rpb[h * 465 + tid] * 1.44269504f;
        __syncthreads();
        const int r = 2 * rp + (wid >> 2), qt = wid & 3, c0 = (qt == 0) ? 0 : (qt == 1 ? 8 : (qt == 2 ? 24 : 32));
        const int rs = min(max(r - 4, 0), 120);
        const size_t qtok = (size_t)b * SEQ + r * 64 + qt * 16 + fr;
        const unsigned lofs = (unsigned)(fr * PW + fq * 8) * 2u;
        const char* qbase = (const char*)(pbuf + ((size_t)b * SEQ + r * 64 + qt * 16) * PW + 512 + h * 64);
        const char* kbase = (const char*)(pbuf + ((size_t)b * SEQ + rs * 64 + c0) * PW + 1024 + h * 64);
        const char* cbase = (const char*)(pbuf + ((size_t)NT + b * CTXL) * PW + 1024 + h * 64);
        const bf16x8 q0 = *(const bf16x8*)(qbase + lofs);
        const bf16x8 q1 = *(const bf16x8*)(qbase + 64 + lofs);
        f32x4 s[32];
#pragma unroll
        for (int t = 0; t < 16; ++t) {
            const unsigned toff = (unsigned)(((t >> 1) * 64 + (t & 1) * 16) * PW * 2);
            const bf16x8 k0 = *(const bf16x8*)(kbase + toff + lofs);
            const bf16x8 k1 = *(const bf16x8*)(kbase + toff + 64 + lofs);
            f32x4 a = (f32x4){0.f, 0.f, 0.f, 0.f};
            a = __builtin_amdgcn_mfma_f32_16x16x32_bf16(k0, q0, a, 0, 0, 0);
            s[t] = __builtin_amdgcn_mfma_f32_16x16x32_bf16(k1, q1, a, 0, 0, 0);
        }
#pragma unroll
        for (int t = 0; t < 16; ++t) {
            const unsigned toff = (unsigned)(t * 16 * PW * 2);
            const bf16x8 k0 = *(const bf16x8*)(cbase + toff + lofs);
            const bf16x8 k1 = *(const bf16x8*)(cbase + toff + 64 + lofs);
            f32x4 a = (f32x4){0.f, 0.f, 0.f, 0.f};
            a = __builtin_amdgcn_mfma_f32_16x16x32_bf16(k0, q0, a, 0, 0, 0);
            s[16 + t] = __builtin_amdgcn_mfma_f32_16x16x32_bf16(k1, q1, a, 0, 0, 0);
        }
        const int cq = qt * 16 + fr, cst = min(max(cq - 8, 0), 48);
        const int vlo = cst - c0 - fq * 4;
        const LAS float* brow = rpbs + (rs - r + 7) * 31 + (15 + c0 + fq * 4 - cq);
        float mx = -1e30f;
#pragma unroll
        for (int t = 0; t < 16; ++t) {
#pragma unroll
            for (int j = 0; j < 4; ++j) { const int off = (t & 1) * 16 + j;
                const float v = ((unsigned)(off - vlo) < 16u) ? s[t][j] + brow[(t >> 1) * 31 + off] : -1e30f; s[t][j] = v; mx = fmaxf(mx, v); }
        }
#pragma unroll
        for (int t = 16; t < 32; ++t)
#pragma unroll
            for (int j = 0; j < 4; ++j) mx = fmaxf(mx, s[t][j]);
        mx = fmaxf(mx, __shfl_xor(mx, 16)); mx = fmaxf(mx, __shfl_xor(mx, 32));
        float sum = 0.f;
#pragma unroll
        for (int t = 0; t < 32; ++t)
#pragma unroll
            for (int j = 0; j < 4; ++j) { const float p = __builtin_amdgcn_exp2f(s[t][j] - mx); s[t][j] = p; sum += p; }
        sum += __shfl_xor(sum, 16); sum += __shfl_xor(sum, 32);
        f32x4 o[4];
#pragma unroll
        for (int dt = 0; dt < 4; ++dt) o[dt] = (f32x4){0.f, 0.f, 0.f, 0.f};
        const int trq = (lane >> 2) & 3, trp = lane & 3;
#pragma unroll
        for (int pi = 0; pi < 16; ++pi) {
            const int t0 = 2 * pi, t1 = 2 * pi + 1;
            int rb0, rb1;
            if (pi < 8) { rb0 = (rs + pi - rs0) * 64 + c0; rb1 = rb0 + 16; } else { rb0 = 576 + (t0 - 16) * 16; rb1 = rb0 + 16; }
            bf16x8 pf; { const unsigned a0 = cvt_pk_bf16(s[t0][0], s[t0][1]), a1 = cvt_pk_bf16(s[t0][2], s[t0][3]), a2 = cvt_pk_bf16(s[t1][0], s[t1][1]), a3 = cvt_pk_bf16(s[t1][2], s[t1][3]);
                u32x4 w = (u32x4){a0, a1, a2, a3}; pf = __builtin_bit_cast(bf16x8, w); }
#pragma unroll
            for (int dt = 0; dt < 4; ++dt) {
                const s16x4 v0 = __builtin_amdgcn_ds_read_tr16_b64_v4i16((LAS s16x4*)(vimg + (rb0 + fq * 4 + trq) * VP + (dt * 16 + trp * 4) * 2));
                const s16x4 v1 = __builtin_amdgcn_ds_read_tr16_b64_v4i16((LAS s16x4*)(vimg + (rb1 + fq * 4 + trq) * VP + (dt * 16 + trp * 4) * 2));
                bf16x8 vf; vf[0] = v0[0]; vf[1] = v0[1]; vf[2] = v0[2]; vf[3] = v0[3]; vf[4] = v1[0]; vf[5] = v1[1]; vf[6] = v1[2]; vf[7] = v1[3];
                o[dt] = __builtin_amdgcn_mfma_f32_16x16x32_bf16(vf, pf, o[dt], 0, 0, 0);
            }
        }
        const float inv = 1.0f / sum;
#pragma unroll
        for (int dt = 0; dt < 4; ++dt)
            *(u32x2*)(cat + qtok * 1024 + 512 + h * 64 + dt * 16 + fq * 4) = (u32x2){cvt_pk_bf16(o[dt][0] * inv, o[dt][1] * inv), cvt_pk_bf16(o[dt][2] * inv, o[dt][3] * inv)};
    }
    __syncthreads();
}

template <int HW>
__device__ __forceinline__ void pool_item(const bf16_t* u, bf16_t* pooled, int t, int chunk) {
    const int tl = t & (SEQ - 1);
    const bf16_t* base = u + (size_t)(t - tl) * DM + chunk * 8;
    float a[8];
#pragma unroll
    for (int i = 0; i < 8; ++i) a[i] = 0.f;
    u32x4 v[2 * HW];
#pragma unroll
    for (int d = 0; d < 2 * HW; ++d) { const int r = tl - HW + d, rc = min(max(r, 0), SEQ - 1); v[d] = *(const u32x4*)(base + (size_t)rc * DM); }
#pragma unroll
    for (int d = 0; d < 2 * HW; ++d) { const int r = tl - HW + d; const float w = (r >= 0 && r < SEQ) ? 1.0f : 0.0f;
        a[0] += w * bf_lo(v[d].x); a[1] += w * bf_hi(v[d].x); a[2] += w * bf_lo(v[d].y); a[3] += w * bf_hi(v[d].y); a[4] += w * bf_lo(v[d].z); a[5] += w * bf_hi(v[d].z); a[6] += w * bf_lo(v[d].w); a[7] += w * bf_hi(v[d].w); }
    const int lo = max(tl - HW, 0), hi = min(tl + HW, SEQ);
    const float ic = 1.0f / (float)(hi - lo);
    const u32x4 c = v[HW];
    u32x4 w; w.x = cvt_pk_bf16(a[0] * ic - bf_lo(c.x), a[1] * ic - bf_hi(c.x)); w.y = cvt_pk_bf16(a[2] * ic - bf_lo(c.y), a[3] * ic - bf_hi(c.y));
    w.z = cvt_pk_bf16(a[4] * ic - bf_lo(c.z), a[5] * ic - bf_hi(c.z)); w.w = cvt_pk_bf16(a[6] * ic - bf_lo(c.w), a[7] * ic - bf_hi(c.w));
    *(u32x4*)(pooled + (size_t)t * DM + chunk * 8) = w;
}
__device__ void pool_pass(const bf16_t* u, bf16_t* pooled) {
    const int lane = threadIdx.x & 63, gw = blockIdx.x * 8 + (threadIdx.x >> 6), nw = gridDim.x * 8;
    for (int wi = gw; wi < (NT / 2) * 4; wi += nw) {
        const int gi = wi & 3, t = (wi >> 2) * 2 + (lane >> 5), chunk = gi * 32 + (lane & 31);
        if (gi == 0) pool_item<1>(u, pooled, t, chunk); else if (gi == 1) pool_item<2>(u, pooled, t, chunk); else if (gi == 2) pool_item<4>(u, pooled, t, chunk); else pool_item<8>(u, pooled, t, chunk);
    }
}

template <int HW>
__device__ __forceinline__ void pool_from_lds(const LAS unsigned char* U, bf16_t* pooled, int t0, int tl0, int tbase, int chunk) {
#pragma unroll 2
    for (int i = 0; i < 8; ++i) {
        const int t = tbase + i, tl = tl0 + t;
        float a[8];
#pragma unroll
        for (int k = 0; k < 8; ++k) a[k] = 0.f;
#pragma unroll
        for (int d = 0; d < 2 * HW; ++d) { const int r = tl - HW + d; const float w = (r >= 0 && r < SEQ) ? 1.0f : 0.0f;
            const u32x4 v = *(const LAS u32x4*)(U + (t + 8 - HW + d) * 2048 + chunk * 16);
            a[0] += w * bf_lo(v.x); a[1] += w * bf_hi(v.x); a[2] += w * bf_lo(v.y); a[3] += w * bf_hi(v.y); a[4] += w * bf_lo(v.z); a[5] += w * bf_hi(v.z); a[6] += w * bf_lo(v.w); a[7] += w * bf_hi(v.w); }
        const int lo = max(tl - HW, 0), hi = min(tl + HW, SEQ);
        const float ic = 1.0f / (float)(hi - lo);
        const u32x4 c = *(const LAS u32x4*)(U + (t + 8) * 2048 + chunk * 16);
        u32x4 w; w.x = cvt_pk_bf16(a[0] * ic - bf_lo(c.x), a[1] * ic - bf_hi(c.x)); w.y = cvt_pk_bf16(a[2] * ic - bf_lo(c.y), a[3] * ic - bf_hi(c.y));
        w.z = cvt_pk_bf16(a[4] * ic - bf_lo(c.z), a[5] * ic - bf_hi(c.z)); w.w = cvt_pk_bf16(a[6] * ic - bf_lo(c.w), a[7] * ic - bf_hi(c.w));
        *(u32x4*)(pooled + (size_t)(t0 + t) * DM + chunk * 8) = w;
    }
}
__device__ void pool_norm_fused(const bf16_t* h, const float* gn, const float* mod, bf16_t* pooled, LAS unsigned char* lds) {
    int tid = threadIdx.x; asm volatile("" : "+v"(tid));
    const int wid = tid >> 6, lane = tid & 63;
    for (int ck = blockIdx.x; ck < NT / 32; ck += gridDim.x) {
        const int t0 = ck * 32, b = t0 >> 13, tl0 = t0 & (SEQ - 1);
        f32x4 gs[4], sh[4];
        load_mod_vecs(gn, mod + (size_t)b * NMOD, mod + (size_t)b * NMOD + 1024, gs, sh, lane);
        __syncthreads();
#pragma unroll 1
        for (int rr = 0; rr < 6; rr += 2) {
            f32x4 v[2][4]; float ss[2];
#pragma unroll
            for (int q = 0; q < 2; ++q) { const int row = wid * 6 + rr + q, tl = min(max(tl0 - 8 + row, 0), SEQ - 1);
#pragma unroll
                for (int j = 0; j < 2; ++j) ld8<true>(h, ((size_t)b * SEQ + tl) * DM + j * 512 + lane * 8, v[q][2 * j], v[q][2 * j + 1]); }
#pragma unroll
            for (int q = 0; q < 2; ++q) { ss[q] = 0.f;
#pragma unroll
                for (int i = 0; i < 4; ++i) ss[q] += v[q][i][0] * v[q][i][0] + v[q][i][1] * v[q][i][1] + v[q][i][2] * v[q][i][2] + v[q][i][3] * v[q][i][3]; }
#pragma unroll
            for (int o = 32; o >= 1; o >>= 1) { ss[0] += __shfl_xor(ss[0], o); ss[1] += __shfl_xor(ss[1], o); }
#pragma unroll
            for (int q = 0; q < 2; ++q) { const float rs = rsqrtf(ss[q] * (1.0f / 1024.0f) + 1e-6f); const int row = wid * 6 + rr + q;
#pragma unroll
                for (int j = 0; j < 2; ++j) { const f32x4 a = v[q][2 * j] * rs * gs[2 * j] + sh[2 * j], c = v[q][2 * j + 1] * rs * gs[2 * j + 1] + sh[2 * j + 1];
                    u32x4 w; w.x = cvt_pk_bf16(a[0], a[1]); w.y = cvt_pk_bf16(a[2], a[3]); w.z = cvt_pk_bf16(c[0], c[1]); w.w = cvt_pk_bf16(c[2], c[3]);
                    *(LAS u32x4*)(lds + row * 2048 + (j * 512 + lane * 8) * 2) = w; } }
        }
        __syncthreads();
        const int g = wid & 3, chunk = g * 32 + (lane & 31), tbase = (wid >> 2) * 16 + (lane >> 5) * 8;
        if (g == 0) pool_from_lds<1>(lds, pooled, t0, tl0, tbase, chunk); else if (g == 1) pool_from_lds<2>(lds, pooled, t0, tl0, tbase, chunk);
        else if (g == 2) pool_from_lds<4>(lds, pooled, t0, tl0, tbase, chunk); else pool_from_lds<8>(lds, pooled, t0, tl0, tbase, chunk);
    }
    __syncthreads();
}

#define XB_TMO      128
#define XB_XCNT(j)  (256  + 64 * (j))
#define XB_XSUB(j)  (1280 + 64 * (j))
#define XB_XGEN(j)  (2304 + 64 * (j))
#define XB_TOP      3328
#define XB_TOPGEN   3392
#define XCD_BAR_WORDS 3456
#define XB_SPIN_CAP (1u << 18)
__device__ __forceinline__ unsigned xb_ld(unsigned* p)              { return __hip_atomic_load(p, __ATOMIC_RELAXED, __HIP_MEMORY_SCOPE_AGENT); }
__device__ __forceinline__ unsigned xb_add(unsigned* p, unsigned v) { return __hip_atomic_fetch_add(p, v, __ATOMIC_RELAXED, __HIP_MEMORY_SCOPE_AGENT); }
__device__ __forceinline__ unsigned xb_xcc_id() { return (unsigned)__builtin_amdgcn_s_getreg((3 << 11) | 20) & 0xFu; }
#define XB_SPIN(cond, bar) do { unsigned _sp = 0; while (cond) { __builtin_amdgcn_s_sleep(1); \
    if ((++_sp & 255u) == 0u) { if (xb_ld(&(bar)[XB_TMO])) break; if (_sp > XB_SPIN_CAP) { atomicAdd(&(bar)[XB_TMO], 1u); break; } } } } while (0)
struct XcdBarrier { unsigned* bar; unsigned x; volatile LAS unsigned* st; };
__device__ __forceinline__ XcdBarrier xcd_barrier_post(unsigned* bar, volatile LAS unsigned* st) {
    XcdBarrier b; b.bar = bar; b.x = xb_xcc_id(); b.st = st;
    if (threadIdx.x == 0) (void)xb_add(&bar[XB_XCNT(b.x)], 1u);
    return b;
}
__device__ __forceinline__ void xcd_barrier_complete(unsigned* bar, unsigned x, unsigned& nloc, unsigned& nx) {
    const unsigned G = gridDim.x * gridDim.y * gridDim.z;
    unsigned sum, cnt, mine, sp = 0u;
    for (;;) {
        sum = 0u; cnt = 0u; mine = 0u;
#pragma unroll
        for (unsigned j = 0; j < 16; ++j) { const unsigned c = xb_ld(&bar[XB_XCNT(j)]); sum += c; cnt += (c > 0u) ? 1u : 0u; mine = (j == x) ? c : mine; }
        if (sum == G) break;
        __builtin_amdgcn_s_sleep(1);
        if ((++sp & 255u) == 0u) { if (xb_ld(&bar[XB_TMO])) break; if (sp > XB_SPIN_CAP) { atomicAdd(&bar[XB_TMO], 1u); break; } }
    }
    nloc = mine > 0u ? mine : 1u; nx = cnt > 0u ? cnt : 1u;
}
__device__ __forceinline__ void xcd_barrier(const XcdBarrier& b) {
    asm volatile("s_waitcnt vmcnt(0)" ::: "memory");
    __syncthreads();
    if (threadIdx.x == 0) {
        unsigned* bar = b.bar;
        __builtin_amdgcn_s_waitcnt(0);
        unsigned nloc = b.st[0], nx = b.st[1];
        if (nloc == 0u) { xcd_barrier_complete(bar, b.x, nloc, nx); b.st[0] = nloc; b.st[1] = nx; }
        const unsigned old = xb_add(&bar[XB_XSUB(b.x)], 1u);
        const unsigned gen = old / nloc;
        if (old + 1u == (gen + 1u) * nloc) {
            __builtin_amdgcn_fence(__ATOMIC_RELEASE, "agent");
            asm volatile("s_waitcnt vmcnt(0)" ::: "memory");
            const unsigned og = xb_add(&bar[XB_TOP], 1u);
            const unsigned tg = og / nx;
            if (og + 1u == (tg + 1u) * nx) xb_add(&bar[XB_TOPGEN], 1u);
            else XB_SPIN(xb_ld(&bar[XB_TOPGEN]) == tg, bar);
            __builtin_amdgcn_fence(__ATOMIC_ACQUIRE, "agent");
            xb_add(&bar[XB_XGEN(b.x)], 1u);
            asm volatile("s_waitcnt vmcnt(0)" ::: "memory");
        } else {
            XB_SPIN(xb_ld(&bar[XB_XGEN(b.x)]) == gen, bar);
            __builtin_amdgcn_fence(__ATOMIC_ACQUIRE, "agent");
            asm volatile("s_waitcnt vmcnt(0)" ::: "memory");
        }
    }
    __syncthreads();
}

__global__ void __launch_bounds__(512, 2) fwd_megakernel(Params P) {
    extern __shared__ __attribute__((aligned(16))) unsigned char shm[];
    LAS unsigned char* lds = (LAS unsigned char*)shm;
    cg::grid_group grid = cg::this_grid();
    volatile LAS unsigned* xst = (volatile LAS unsigned*)(lds + LDS_BYTES - 16);
    if (threadIdx.x == 0) { xst[0] = 0u; xst[1] = 0u; }
    __syncthreads();
    const XcdBarrier xb = xcd_barrier_post((unsigned*)(P.ws + WS_CTL), xst);
#define GSYNC(n) xcd_barrier(xb)
    unsigned char* ws = P.ws;
    const float* mod0 = (const float*)(ws + WS_MOD0); const float* mod1 = (const float*)(ws + WS_MOD1);
    bf16_t* ubuf = (bf16_t*)(ws + WS_U);
    bf16_t* pbuf = (bf16_t*)(ws + WS_BIG + BIG_P);
    bf16_t* cat = (bf16_t*)(ws + WS_BIG + BIG_CAT);
    bf16_t* abuf = (bf16_t*)(ws + WS_BIG + BIG_A);
    bf16_t* pooled = (bf16_t*)(ws + WS_BIG + BIG_POOL);

    grid.sync();
    phase0(P, lds);
    GSYNC(1);
    bf16_t* hres = (bf16_t*)(ws + WS_H);
    norm_pass<false>(P.x, ubuf, P.norm1_g, mod0, 0, &P, hres);
    GSYNC(2);
    { Gemm g{ubuf, (const bf16_t*)(ws + WS_WIN), DM, DM, DM, (NT + NCTX) / 256, PW / 256, 0, 0, 0}; EpiProj E{pbuf, P.q_g, P.k_g}; gemm_phase(lds, g, E); }
    GSYNC(3);
    natten_phase(P, lds);
    dft_stage1(P, lds);
    GSYNC(4);
    dft_stage2(P, lds);
    GSYNC(5);
    { Gemm g{cat, (const bf16_t*)(ws + WS_WOUT), DM, DM, DM, NT / 256, DM / 256, 0, 0, 0}; EpiResT<true, true> E{hres, hres, mod0 + 2048, nullptr}; gemm_phase(lds, g, E); }
    GSYNC(6);
    norm_pass<true>(hres, ubuf, P.norm2_g, mod0, 1, nullptr);
    GSYNC(7);
    { Gemm g{ubuf, (const bf16_t*)(ws + WS_W1), DM, DM, DM, NT / 256, HID / 256, 0, 0, 0}; EpiAct E{abuf, HID}; gemm_phase(lds, g, E); }
    GSYNC(8);
    { Gemm g{abuf, (const bf16_t*)(ws + WS_W2), HID, HID, HID, NT / 256, DM / 256, 0, HID / 64, HID / 64, 1}; EpiResT<true, true> E{hres, hres, mod0 + 5120, nullptr}; gemm_phase(lds, g, E); }
    GSYNC(9);
    pool_norm_fused(hres, P.norm1_g + DM, mod1, pooled, lds);
    GSYNC(11);
    { Gemm g{pooled, (const bf16_t*)(ws + WS_WPOOL), DM, 256, 256, NT / 256, 4, 512, 0, 0}; EpiResT<true, true> E{hres, hres, mod1 + 2048, P.pool_scale}; gemm_phase(lds, g, E); }
    GSYNC(12);
    norm_pass<true>(hres, ubuf, P.norm2_g + DM, mod1, 1, nullptr);
    GSYNC(13);
    { Gemm g{ubuf, (const bf16_t*)(ws + WS_W1) + (size_t)HID * DM, DM, DM, DM, NT / 256, HID / 256, 0, 0, 0}; EpiAct E{abuf, HID}; gemm_phase(lds, g, E); }
    GSYNC(14);
    { Gemm g{abuf, (const bf16_t*)(ws + WS_W2) + (size_t)DM * HID, HID, HID, HID, NT / 256, DM / 256, 0, HID / 64, HID / 64, 1}; EpiResT<true, false> E{hres, P.out, mod1 + 5120, nullptr}; gemm_phase(lds, g, E); }
}

extern "C" void kernel_launch(void* const* d_in, const int* in_sizes, int n_in, void* d_out, int out_size, void* d_ws, size_t ws_size, hipStream_t stream) {
    static int grid_blocks = 0;
    if (grid_blocks == 0) {
        if (n_in != 18 || out_size != NT * DM || ws_size < WS_END) { fprintf(stderr, "kernel_launch: unexpected shapes (n_in %d out %d ws %zu need %zu)\n", n_in, out_size, ws_size, (size_t)WS_END); grid_blocks = -1; return; }
        int dev = 0, cus = 0, per_cu = 0;
        (void)hipGetDevice(&dev);
        (void)hipDeviceGetAttribute(&cus, hipDeviceAttributeMultiprocessorCount, dev);
        if (hipFuncSetAttribute((const void*)fwd_megakernel, hipFuncAttributeMaxDynamicSharedMemorySize, LDS_BYTES) != hipSuccess) { fprintf(stderr, "kernel_launch: hipFuncSetAttribute failed\n"); grid_blocks = -1; return; }
        if (hipOccupancyMaxActiveBlocksPerMultiprocessor(&per_cu, (const void*)fwd_megakernel, 512, LDS_BYTES) != hipSuccess || per_cu < 1) { fprintf(stderr, "kernel_launch: occupancy query failed (%d)\n", per_cu); (void)hipGetLastError(); per_cu = 1; }
        grid_blocks = cus * 1;
        (void)per_cu;
    }
    if (grid_blocks < 0) return;
    Params p{};
    p.x = (const float*)d_in[0]; p.c = (const float*)d_in[1]; p.ctx = (const float*)d_in[2]; p.c_ctx = (const float*)d_in[3]; p.w_mod = (const float*)d_in[4]; p.b_mod = (const float*)d_in[5];
    p.norm1_g = (const float*)d_in[6]; p.norm2_g = (const float*)d_in[7]; p.w_in = (const float*)d_in[8]; p.w_four = (const float*)d_in[9]; p.q_g = (const float*)d_in[10]; p.k_g = (const float*)d_in[11];
    p.rpb = (const float*)d_in[12]; p.w_out = (const float*)d_in[13]; p.w_pool = (const float*)d_in[14]; p.pool_scale = (const float*)d_in[15]; p.w_mlp1 = (const float*)d_in[16]; p.w_mlp2 = (const float*)d_in[17];
    p.out = (float*)d_out; p.ws = (unsigned char*)d_ws;
    if (hipMemsetAsync((char*)d_ws + WS_CTL, 0, 16384, stream) != hipSuccess) { fprintf(stderr, "kernel_launch: memset failed\n"); return; }
    void* args[] = {&p};
    hipError_t e = hipLaunchCooperativeKernel((const void*)fwd_megakernel, dim3(grid_blocks), dim3(512), args, LDS_BYTES, stream);
    if (e != hipSuccess) fprintf(stderr, "kernel_launch: cooperative launch failed: %s (grid %d)\n", hipGetErrorString(e), grid_blocks);
}
```
